# Optimizing an MI355X kernel written in HIP

```python
import math
import jax
import jax.numpy as jnp
from jax import lax
import numpy as np

D_MODEL = 1024
BATCH = 16
SEQ = 2048
DEPTH = 4

N_MIXERS = 3
HEAD_DIM = 64
N_SCORE_HEADS = 16
DIFF_HEADS = D_MODEL // (2 * HEAD_DIM)
DIFF_QK_WIDTH = DIFF_HEADS * 2 * HEAD_DIM
DIFF_V_DIM = 2 * HEAD_DIM
MOBA_HEADS = D_MODEL // HEAD_DIM
MOBA_BLOCK = 256
MOBA_TOPK = 3
NSA_HEADS = D_MODEL // HEAD_DIM
NSA_KV_GROUPS = 4
NSA_GROUP_SIZE = NSA_HEADS // NSA_KV_GROUPS
NSA_CMP_BLOCK = 32
NSA_CMP_STRIDE = 16
NSA_CMP_HIDDEN = 256
NSA_SEL_BLOCK = 64
NSA_SEL_TOPK = 16
NSA_WINDOW = 512
NSA_KV_WIDTH = NSA_KV_GROUPS * HEAD_DIM
NSA_IN_WIDTH = NSA_HEADS * HEAD_DIM + 6 * NSA_KV_WIDTH + 3 * NSA_HEADS
REL_BUCKETS = 32
REL_MAX_DIST = 1024
FFN_DIM = 3584
N_EXPERTS = 8
TOP_K_EXPERTS = 2
QUERY_BLOCK = 128
SPARSE_QUERY_BLOCK = 64
NORM_EPS = 1e-6
NEG_INF = -1e30
FORCE_SCORE = 1e30
ATTN_SCALE = HEAD_DIM ** -0.5

kernel_name = 'hybrid_diff_moba_nsa_moe_trunk'


def rms_norm(x, gain):
    xf = x.astype(jnp.float32)
    y = xf * lax.rsqrt(jnp.mean(xf * xf, axis=-1, keepdims=True) + NORM_EPS)
    return (y * gain.astype(jnp.float32)).astype(x.dtype)


def masked_softmax(logits, mask):
    logits = jnp.where(mask, logits, NEG_INF)
    m = jnp.max(logits, axis=-1, keepdims=True)
    p = jnp.where(mask, jnp.exp(logits - m), 0.0)
    return p / jnp.maximum(jnp.sum(p, axis=-1, keepdims=True), 1e-30)


def rel_bucket(dist):
    n = jnp.maximum(dist, 0)
    max_exact = REL_BUCKETS // 2
    nf = jnp.maximum(n, max_exact).astype(jnp.float32)
    large = max_exact + (jnp.log(nf / max_exact) / math.log(REL_MAX_DIST / max_exact)
                         * (REL_BUCKETS - max_exact)).astype(jnp.int32)
    return jnp.where(n < max_exact, n, jnp.minimum(large, REL_BUCKETS - 1))


def diff_lambda_init(layer):
    return 0.8 - 0.6 * math.exp(-0.3 * layer)


def differential_attention(h, w_in, w_out, q_gain, k_gain, lam_q1, lam_k1, lam_q2, lam_k2,
                           subln_gain, rel_bias, lambda_init):
    B, S, _ = h.shape
    q, k, v = jnp.split(h @ w_in, [DIFF_QK_WIDTH, 2 * DIFF_QK_WIDTH], axis=-1)
    q = rms_norm(q.reshape(B, S, DIFF_HEADS, 2, HEAD_DIM), q_gain)
    k = rms_norm(k.reshape(B, S, DIFF_HEADS, 2, HEAD_DIM), k_gain)
    v = v.reshape(B, S, DIFF_HEADS, DIFF_V_DIM)
    lam = (jnp.exp(jnp.sum((lam_q1 * lam_k1).astype(jnp.float32)))
           - jnp.exp(jnp.sum((lam_q2 * lam_k2).astype(jnp.float32))) + lambda_init)
    n_qb = S // QUERY_BLOCK
    q_blocks = q.reshape(B, n_qb, QUERY_BLOCK, DIFF_HEADS, 2, HEAD_DIM).swapaxes(0, 1)
    key_pos = jnp.arange(S)

    def block(args):
        qb, start = args
        dist = (start + jnp.arange(QUERY_BLOCK))[:, None] - key_pos[None, :]
        bias = rel_bias[rel_bucket(dist)].astype(jnp.float32)
        bias = bias.reshape(QUERY_BLOCK, S, DIFF_HEADS, 2).transpose(2, 3, 0, 1)
        logits = jnp.einsum('bqhmd,bkhmd->bhmqk', qb, k).astype(jnp.float32) * ATTN_SCALE + bias
        p = masked_softmax(logits, dist >= 0)
        a = p[:, :, 0] - lam * p[:, :, 1]
        return jnp.einsum('bhqk,bkhe->bqhe', a, v)

    o = lax.map(block, (q_blocks, jnp.arange(n_qb) * QUERY_BLOCK))
    o = o.swapaxes(0, 1).reshape(B, S, DIFF_HEADS, DIFF_V_DIM)
    o = rms_norm(o, subln_gain) * (1.0 - lambda_init)
    return o.reshape(B, S, DIFF_HEADS * DIFF_V_DIM).astype(h.dtype) @ w_out


def moba_attention(h, w_in, w_out, q_gain, k_gain, rel_bias):
    B, S, _ = h.shape
    H, d = MOBA_HEADS, HEAD_DIM
    q, k, v = jnp.split(h @ w_in, 3, axis=-1)
    q = rms_norm(q.reshape(B, S, H, d), q_gain).transpose(0, 2, 1, 3)
    k = rms_norm(k.reshape(B, S, H, d), k_gain).transpose(0, 2, 1, 3)
    v = v.reshape(B, S, H, d).transpose(0, 2, 1, 3)
    n_blk = -(-S // MOBA_BLOCK)
    pad = ((0, 0), (0, 0), (0, n_blk * MOBA_BLOCK - S), (0, 0))
    k = jnp.pad(k, pad)
    v = jnp.pad(v, pad)
    k_mean = jnp.mean(k.reshape(B, H, n_blk, MOBA_BLOCK, d).astype(jnp.float32), axis=3)
    topk = min(MOBA_TOPK, n_blk)
    Qc = SPARSE_QUERY_BLOCK
    n_sel_keys = topk * MOBA_BLOCK
    table = rel_bias.T
    h_ix = jnp.arange(H)[:, None, None]

    def per_seq(args):
        qs, ks, vs, km = args
        k_blk = ks.reshape(H, n_blk, MOBA_BLOCK, d)
        v_blk = vs.reshape(H, n_blk, MOBA_BLOCK, d)

        def chunk(start):
            qc = lax.dynamic_slice_in_dim(qs, start, Qc, axis=1)
            q_pos = start + jnp.arange(Qc)
            cur = start // MOBA_BLOCK
            gate = jnp.einsum('hqd,hnd->hqn', qc.astype(jnp.float32), km)
            gate = jnp.where(jnp.arange(n_blk) < cur, gate, NEG_INF)
            _, idx = lax.top_k(gate, topk)
            valid = jnp.repeat(idx < cur, MOBA_BLOCK, axis=-1)
            k_sel = k_blk[h_ix, idx].reshape(H, Qc, n_sel_keys, d)
            v_sel = v_blk[h_ix, idx].reshape(H, Qc, n_sel_keys, d)
            sel_pos = (idx[..., None] * MOBA_BLOCK + jnp.arange(MOBA_BLOCK)).reshape(H, Qc, n_sel_keys)
            sel_bias = table[h_ix, rel_bucket(q_pos[None, :, None] - sel_pos)]
            sel_logits = jnp.einsum('hqd,hqkd->hqk', qc, k_sel).astype(jnp.float32) * ATTN_SCALE + sel_bias
            own_start = cur * MOBA_BLOCK
            k_own = lax.dynamic_slice_in_dim(ks, own_start, MOBA_BLOCK, axis=1)
            v_own = lax.dynamic_slice_in_dim(vs, own_start, MOBA_BLOCK, axis=1)
            own_dist = q_pos[:, None] - (own_start + jnp.arange(MOBA_BLOCK))[None, :]
            own_logits = (jnp.einsum('hqd,hkd->hqk', qc, k_own).astype(jnp.float32) * ATTN_SCALE
                          + table[:, rel_bucket(own_dist)])
            logits = jnp.concatenate([sel_logits, own_logits], axis=-1)
            mask = jnp.concatenate([valid, jnp.broadcast_to(own_dist >= 0, (H, Qc, MOBA_BLOCK))], axis=-1)
            p = masked_softmax(logits, mask)
            return (jnp.einsum('hqk,hqkd->hqd', p[..., :n_sel_keys], v_sel)
                    + jnp.einsum('hqk,hkd->hqd', p[..., n_sel_keys:], v_own))

        o = lax.map(chunk, jnp.arange(S // Qc) * Qc)
        return o.transpose(1, 0, 2, 3).reshape(H, S, d)

    o = lax.map(per_seq, (q, k, v, k_mean))
    return o.transpose(0, 2, 1, 3).reshape(B, S, H * d).astype(h.dtype) @ w_out


def nsa_attention(h, w_in, w_out, q_gain, k_gain, cmp_pos_k, cmp_pos_v, cmp_k_w1, cmp_k_w2,
                  cmp_v_w1, cmp_v_w2, rel_bias):
    B, S, _ = h.shape
    G, R, d = NSA_KV_GROUPS, NSA_GROUP_SIZE, HEAD_DIM
    splits = np.cumsum([NSA_HEADS * d] + [NSA_KV_WIDTH] * 6).tolist()
    q, kc, vc, ks, vs, kw, vw, g = jnp.split(h @ w_in, splits, axis=-1)
    q = rms_norm(q.reshape(B, S, G, R, d), q_gain)
    gates = jax.nn.sigmoid(g.astype(jnp.float32)).reshape(B, S, G, R, 3)

    n_cmp = (S - NSA_CMP_BLOCK) // NSA_CMP_STRIDE + 1
    cmp_start = jnp.arange(n_cmp) * NSA_CMP_STRIDE
    win_idx = cmp_start[:, None] + jnp.arange(NSA_CMP_BLOCK)[None, :]

    def compress(x, pos, w1, w2):
        xw = x.reshape(B, S, G, d)[:, win_idx] + pos[:, None, :]
        xw = xw.transpose(0, 1, 3, 2, 4).reshape(B, n_cmp, G, NSA_CMP_BLOCK * d)
        return jax.nn.gelu(xw @ w1) @ w2

    k_cmp = rms_norm(compress(kc, cmp_pos_k, cmp_k_w1, cmp_k_w2), k_gain[0])
    v_cmp = compress(vc, cmp_pos_v, cmp_v_w1, cmp_v_w2)
    k_slc = rms_norm(ks.reshape(B, S, G, d), k_gain[1])
    v_slc = vs.reshape(B, S, G, d)
    pad_w = ((0, 0), (NSA_WINDOW, 0), (0, 0), (0, 0))
    k_win = jnp.pad(rms_norm(kw.reshape(B, S, G, d), k_gain[2]), pad_w)
    v_win = jnp.pad(vw.reshape(B, S, G, d), pad_w)

    n_sel = S // NSA_SEL_BLOCK
    topk = min(NSA_SEL_TOPK, n_sel)
    n_sel_keys = topk * NSA_SEL_BLOCK
    sel_start = jnp.arange(n_sel) * NSA_SEL_BLOCK
    overlap = jnp.clip(jnp.minimum(cmp_start[:, None] + NSA_CMP_BLOCK, sel_start[None, :] + NSA_SEL_BLOCK)
                       - jnp.maximum(cmp_start[:, None], sel_start[None, :]), 0).astype(jnp.float32) / NSA_CMP_STRIDE
    cmp_last = cmp_start + NSA_CMP_BLOCK - 1
    table = rel_bias.T.reshape(G, R, REL_BUCKETS)
    g_ix = jnp.arange(G)
    r_ix = jnp.arange(R)
    Qc = SPARSE_QUERY_BLOCK
    win_len = NSA_WINDOW + Qc

    def per_seq(args):
        qs, kcs, vcs, kss, vss, kws, vws = args
        k_blk = kss.reshape(n_sel, NSA_SEL_BLOCK, G, d).transpose(2, 0, 1, 3)
        v_blk = vss.reshape(n_sel, NSA_SEL_BLOCK, G, d).transpose(2, 0, 1, 3)

        def chunk(start):
            qc = lax.dynamic_slice_in_dim(qs, start, Qc, axis=0)
            q_pos = start + jnp.arange(Qc)
            c_logits = jnp.einsum('qgrd,ngd->grqn', qc, kcs).astype(jnp.float32) * ATTN_SCALE
            p_cmp = masked_softmax(c_logits, cmp_last[None, :] <= q_pos[:, None])
            o_cmp = jnp.einsum('grqn,ngd->qgrd', p_cmp, vcs)
            blk = jnp.arange(n_sel)
            cur = (q_pos // NSA_SEL_BLOCK)[:, None]
            imp = jnp.einsum('gqn,ns->gqs', jnp.sum(p_cmp, axis=1), overlap)
            forced = (blk == 0) | (blk == cur) | (blk == cur - 1)
            imp = jnp.where(forced, FORCE_SCORE, jnp.where(blk <= cur, imp, NEG_INF))
            _, idx = lax.top_k(imp, topk)
            k_sel = k_blk[g_ix[:, None, None], idx].reshape(G, Qc, n_sel_keys, d)
            v_sel = v_blk[g_ix[:, None, None], idx].reshape(G, Qc, n_sel_keys, d)
            sel_pos = (idx[..., None] * NSA_SEL_BLOCK + jnp.arange(NSA_SEL_BLOCK)).reshape(G, Qc, n_sel_keys)
            sel_dist = q_pos[None, :, None] - sel_pos
            sel_bias = table[g_ix[:, None, None, None], r_ix[None, :, None, None], rel_bucket(sel_dist)[:, None]]
            s_logits = jnp.einsum('qgrd,gqkd->grqk', qc, k_sel).astype(jnp.float32) * ATTN_SCALE + sel_bias
            p_sel = masked_softmax(s_logits, (sel_dist >= 0)[:, None])
            o_sel = jnp.einsum('grqk,gqkd->qgrd', p_sel, v_sel)
            k_w = lax.dynamic_slice_in_dim(kws, start, win_len, axis=0)
            v_w = lax.dynamic_slice_in_dim(vws, start, win_len, axis=0)
            w_pos = start - NSA_WINDOW + jnp.arange(win_len)
            w_dist = q_pos[:, None] - w_pos[None, :]
            w_mask = (w_dist >= 0) & (w_dist < NSA_WINDOW) & (w_pos >= 0)[None, :]
            w_logits = (jnp.einsum('qgrd,kgd->grqk', qc, k_w).astype(jnp.float32) * ATTN_SCALE
                        + table[:, :, rel_bucket(w_dist)])
            p_w = masked_softmax(w_logits, w_mask)
            o_w = jnp.einsum('grqk,kgd->qgrd', p_w, v_w)
            return jnp.stack([o_cmp, o_sel, o_w], axis=-1)

        out = lax.map(chunk, jnp.arange(S // Qc) * Qc)
        return out.reshape(S, G, R, d, 3)

    out = lax.map(per_seq, (q, k_cmp, v_cmp, k_slc, v_slc, k_win, v_win))
    o = jnp.sum(out * gates[..., None, :], axis=-1)
    return o.reshape(B, S, NSA_HEADS * d).astype(h.dtype) @ w_out


def swiglu(h, w_gate, w_up, w_down):
    return (jax.nn.silu(h @ w_gate) * (h @ w_up)) @ w_down


def moe_swiglu(h, w_router, b_router, we_gate, we_up, we_down):
    B, S, D = h.shape
    t = h.reshape(B * S, D)
    logits = (t @ w_router).astype(jnp.float32) + b_router.astype(jnp.float32)
    top_val, top_idx = lax.top_k(logits, TOP_K_EXPERTS)
    weights = jax.nn.softmax(top_val, axis=-1)
    gate = jnp.sum(jax.nn.one_hot(top_idx, N_EXPERTS, dtype=jnp.float32) * weights[..., None], axis=1)
    out = jnp.zeros_like(t)
    for e in range(N_EXPERTS):
        out = out + gate[:, e:e + 1].astype(t.dtype) * swiglu(t, we_gate[e], we_up[e], we_down[e])
    return out.reshape(B, S, D)


def setup_inputs(seed: int = 0) -> dict:
    keys = iter(jax.random.split(jax.random.key(seed), 96))
    D = D_MODEL

    def normal(shape, scale):
        return jax.random.normal(next(keys), shape, jnp.float32) * scale

    def gain(shape):
        return 1.0 + normal(shape, 0.02)

    inp = {'x': normal((BATCH, SEQ, D), 1.0),
           'rel_bias': normal((REL_BUCKETS, N_SCORE_HEADS), 0.3)}

    def add_diff(p):
        inp[p + 'w_in'] = normal((D, 2 * DIFF_QK_WIDTH + DIFF_HEADS * DIFF_V_DIM), D ** -0.5)
        inp[p + 'w_out'] = normal((DIFF_HEADS * DIFF_V_DIM, D), (DIFF_HEADS * DIFF_V_DIM) ** -0.5)
        inp[p + 'q_gain'] = gain((HEAD_DIM,))
        inp[p + 'k_gain'] = gain((HEAD_DIM,))
        for n in ('lam_q1', 'lam_k1', 'lam_q2', 'lam_k2'):
            inp[p + n] = normal((HEAD_DIM,), 0.1)
        inp[p + 'subln_gain'] = gain((DIFF_V_DIM,))

    def add_moba(p):
        inp[p + 'w_in'] = normal((D, 3 * MOBA_HEADS * HEAD_DIM), D ** -0.5)
        inp[p + 'w_out'] = normal((MOBA_HEADS * HEAD_DIM, D), (MOBA_HEADS * HEAD_DIM) ** -0.5)
        inp[p + 'q_gain'] = gain((HEAD_DIM,))
        inp[p + 'k_gain'] = gain((HEAD_DIM,))

    def add_nsa(p):
        inp[p + 'w_in'] = normal((D, NSA_IN_WIDTH), D ** -0.5)
        inp[p + 'w_out'] = normal((NSA_HEADS * HEAD_DIM, D), (NSA_HEADS * HEAD_DIM) ** -0.5)
        inp[p + 'q_gain'] = gain((HEAD_DIM,))
        inp[p + 'k_gain'] = gain((3, HEAD_DIM))
        inp[p + 'cmp_pos_k'] = normal((NSA_CMP_BLOCK, HEAD_DIM), 0.1)
        inp[p + 'cmp_pos_v'] = normal((NSA_CMP_BLOCK, HEAD_DIM), 0.1)
        for n in ('k', 'v'):
            inp[p + 'cmp_' + n + '_w1'] = normal((NSA_CMP_BLOCK * HEAD_DIM, NSA_CMP_HIDDEN), (NSA_CMP_BLOCK * HEAD_DIM) ** -0.5)
            inp[p + 'cmp_' + n + '_w2'] = normal((NSA_CMP_HIDDEN, HEAD_DIM), NSA_CMP_HIDDEN ** -0.5)

    def add_dense(p):
        inp[p + 'w_gate'] = normal((D, FFN_DIM), D ** -0.5)
        inp[p + 'w_up'] = normal((D, FFN_DIM), D ** -0.5)
        inp[p + 'w_down'] = normal((FFN_DIM, D), FFN_DIM ** -0.5)

    def add_moe(p):
        inp[p + 'w_router'] = normal((D, N_EXPERTS), D ** -0.5)
        inp[p + 'b_router'] = normal((N_EXPERTS,), 0.01)
        inp[p + 'we_gate'] = normal((N_EXPERTS, D, FFN_DIM), D ** -0.5)
        inp[p + 'we_up'] = normal((N_EXPERTS, D, FFN_DIM), D ** -0.5)
        inp[p + 'we_down'] = normal((N_EXPERTS, FFN_DIM, D), FFN_DIM ** -0.5)

    mixer_builders = (add_diff, add_moba, add_nsa)
    for i in range(DEPTH):
        p = f'l{i}_'
        inp[p + 'norm_mix'] = gain((D,))
        mixer_builders[i % N_MIXERS](p)
        inp[p + 'norm_ffn'] = gain((D,))
        (add_dense if i % 2 == 0 else add_moe)(p)
    return inp


def reference(x, rel_bias,
              l0_norm_mix, l0_w_in, l0_w_out, l0_q_gain, l0_k_gain, l0_lam_q1, l0_lam_k1, l0_lam_q2, l0_lam_k2,
              l0_subln_gain, l0_norm_ffn, l0_w_gate, l0_w_up, l0_w_down,
              l1_norm_mix, l1_w_in, l1_w_out, l1_q_gain, l1_k_gain, l1_norm_ffn, l1_w_router, l1_b_router,
              l1_we_gate, l1_we_up, l1_we_down,
              l2_norm_mix, l2_w_in, l2_w_out, l2_q_gain, l2_k_gain, l2_cmp_pos_k, l2_cmp_pos_v, l2_cmp_k_w1,
              l2_cmp_k_w2, l2_cmp_v_w1, l2_cmp_v_w2, l2_norm_ffn, l2_w_gate, l2_w_up, l2_w_down,
              l3_norm_mix, l3_w_in, l3_w_out, l3_q_gain, l3_k_gain, l3_lam_q1, l3_lam_k1, l3_lam_q2, l3_lam_k2,
              l3_subln_gain, l3_norm_ffn, l3_w_router, l3_b_router, l3_we_gate, l3_we_up, l3_we_down):
    layers = [
        (l0_norm_mix, (l0_w_in, l0_w_out, l0_q_gain, l0_k_gain, l0_lam_q1, l0_lam_k1, l0_lam_q2, l0_lam_k2, l0_subln_gain),
         l0_norm_ffn, (l0_w_gate, l0_w_up, l0_w_down)),
        (l1_norm_mix, (l1_w_in, l1_w_out, l1_q_gain, l1_k_gain),
         l1_norm_ffn, (l1_w_router, l1_b_router, l1_we_gate, l1_we_up, l1_we_down)),
        (l2_norm_mix, (l2_w_in, l2_w_out, l2_q_gain, l2_k_gain, l2_cmp_pos_k, l2_cmp_pos_v,
                       l2_cmp_k_w1, l2_cmp_k_w2, l2_cmp_v_w1, l2_cmp_v_w2),
         l2_norm_ffn, (l2_w_gate, l2_w_up, l2_w_down)),
        (l3_norm_mix, (l3_w_in, l3_w_out, l3_q_gain, l3_k_gain, l3_lam_q1, l3_lam_k1, l3_lam_q2, l3_lam_k2, l3_subln_gain),
         l3_norm_ffn, (l3_w_router, l3_b_router, l3_we_gate, l3_we_up, l3_we_down)),
    ]
    h = x
    for i in range(DEPTH):
        norm_mix, mix_p, norm_ffn, ffn_p = layers[i]
        hn = rms_norm(h, norm_mix)
        kind = i % N_MIXERS
        if kind == 0:
            mixed = differential_attention(hn, *mix_p, rel_bias, diff_lambda_init(i))
        elif kind == 1:
            mixed = moba_attention(hn, *mix_p, rel_bias)
        else:
            mixed = nsa_attention(hn, *mix_p, rel_bias)
        h = h + mixed.astype(h.dtype)
        hn = rms_norm(h, norm_ffn)
        if i % 2 == 0:
            f = swiglu(hn, *ffn_p)
        else:
            f = moe_swiglu(hn, *ffn_p)
        h = h + f.astype(h.dtype)
    return h
```

```cpp
#include <hip/hip_runtime.h>
#include <cstdio>
#include <cstdint>
namespace pg8 {
#define PG8_LAS __attribute__((address_space(3)))
typedef unsigned short bf16_t;
typedef short bf16x8 __attribute__((ext_vector_type(8)));
typedef float f32x4 __attribute__((ext_vector_type(4)));
typedef float f32x2 __attribute__((ext_vector_type(2)));
typedef unsigned u32x4 __attribute__((ext_vector_type(4)));
constexpr int BM = 256, BK = 64, HALF = 128, HTB = HALF * BK * 2  , STAGE_BYTES = 8 * HTB, NXCD = 8, WGM = 8;

__host__ __device__ __forceinline__ int lds_byte(int r, int c) { const int st = (r >> 4) * 2 + (c >> 5), rr = r & 15, cc = c & 31, ob = rr * 64 + cc * 2; return st * 1024 + (ob ^ (((ob >> 9) & 1) << 5)); }
__host__ __device__ __forceinline__ void stage_rc(int b, int& R, int& C) { const int st = b / 1024, sb = b % 1024, swz = sb ^ (((sb >> 9) & 1) << 5); R = (st >> 1) * 16 + swz / 64; C = (st & 1) * 32 + (swz % 64) / 2; }
__host__ __device__ __forceinline__ int perm32(int rho) { const int n = rho >> 4, i = rho & 15; return 8 * (i >> 2) + 4 * n + (i & 3); }

struct Unit { int pm, pn, aux; size_t boff; };
struct Gemm { const void* A; const void* Bt; int nt; unsigned rowB; unsigned kstepA; };
typedef int i32x4 __attribute__((ext_vector_type(4)));
template <bool I8> struct AccSel { typedef f32x4 T; }; template <> struct AccSel<true> { typedef i32x4 T; };

__device__ __forceinline__ void swz_order(int L, int nM, int nN, int& pm, int& pn) {
    const int nwg = nM * nN; int wgid = L;
    { const int q = nwg / NXCD, r = nwg % NXCD, xcd = wgid % NXCD, off = wgid / NXCD; wgid = (xcd < r ? xcd * (q + 1) : r * (q + 1) + (xcd - r) * q) + off; }
    const int nig = WGM * nN, gid = wgid / nig, fm = gid * WGM, gsz = (nM - fm) < WGM ? (nM - fm) : WGM;
    pm = fm + ((wgid % nig) % gsz); pn = (wgid % nig) / gsz;
}

struct PlainSched {
    int nM, nN, nwg, G, c; unsigned lda2; size_t tstepB;
    __device__ __forceinline__ void init(int M, int N, unsigned rowB, unsigned rowA, int G_, int c_) { nM = M / BM; nN = N / BM; nwg = nM * nN; G = G_; c = c_; lda2 = rowA; tstepB = (size_t)BM * rowB; }
    __device__ __forceinline__ bool next(int i, Unit& u) const {
        const long L = (long)i * G + c; if (L >= nwg) return false;
        swz_order((int)L, nM, nN, u.pm, u.pn); u.aux = 0; u.boff = (size_t)u.pn * tstepB; return true;
    }
    __device__ __forceinline__ unsigned arow(const Unit& u, int r) const { return (unsigned)(u.pm * BM + r) * lda2; }
};
struct MoeSched {
    int nM, nN, nwg, G, c; unsigned lda2; size_t tstepB, estepB; const PG8_LAS int* tile_e; const int* tok;
    __device__ __forceinline__ void init(int ntile, int N, unsigned rowB, unsigned rowA, size_t estepB_, int G_, int c_, const PG8_LAS int* te, const int* tk) { nM = ntile; nN = N / BM; nwg = nM * nN; G = G_; c = c_; lda2 = rowA; tstepB = (size_t)BM * rowB; estepB = estepB_; tile_e = te; tok = tk; }
    __device__ __forceinline__ bool next(int i, Unit& u) const {
        const long L = (long)i * G + c; if (L >= nwg) return false;
        swz_order((int)L, nM, nN, u.pm, u.pn); const int e = __builtin_amdgcn_readfirstlane(tile_e[u.pm]); u.aux = e; u.boff = (size_t)e * estepB + (size_t)u.pn * tstepB; return true;
    }
    __device__ __forceinline__ unsigned arow(const Unit& u, int r) const { const int row = u.pm * BM + r; return (unsigned)(tok ? tok[row] : row) * lda2; }
};
struct CmpSched {
    int G, c; unsigned pitch2; unsigned col0;
    __device__ __forceinline__ bool next(int i, Unit& u) const {
        const int L = i * G + c; if (L >= 64) return false;
        u.aux = L >> 5; u.pm = L & 31; u.pn = 0; u.boff = (size_t)u.aux * (256u * 2048u * 2u); return true;
    }
    __device__ __forceinline__ unsigned arow(const Unit& u, int r) const {
        const int rho = u.pm * BM + r, bg = rho >> 7; int n = rho & 127; n = n > 126 ? 126 : n;
        const int b = bg >> 2, g = bg & 3;
        return (unsigned)(b * 2048 + 16 * n) * pitch2 + (col0 + (unsigned)u.aux * 256u + (unsigned)g * 64u) * 2u;
    }
};

__device__ __forceinline__ unsigned cvt_pk_bf16(float lo, float hi) { unsigned r; asm volatile("v_cvt_pk_bf16_f32 %0, %1, %2" : "=v"(r) : "v"(lo), "v"(hi)); return r; }

template <class T, class = void> struct has_prefetch { static constexpr bool value = false; };
template <class T> struct has_prefetch<T, decltype((void)&T::prefetch)> { static constexpr bool value = true; };
template <class Epi, class Sched, bool ALIGN_EPI, bool I8 = false>
__device__ __forceinline__ void gemm_phase(PG8_LAS unsigned char* lds, const Gemm g, const Sched& S, const Epi& E) {
    const int tid = threadIdx.x, wid = __builtin_amdgcn_readfirstlane(tid >> 6), lane = tid & 63, wr = wid >> 2, wc = wid & 3, fr = lane & 15, fq = lane >> 4;
    const int nt = g.nt; const unsigned rowB = g.rowB;
    int Rr[2], Cc[2]; unsigned voffB[2];
#pragma unroll
    for (int i = 0; i < 2; ++i) { int R, C; stage_rc(tid * 16 + i * 8192, R, C); const int Rb = (R & ~31) + perm32(R & 31); Rr[i] = R; Cc[i] = C; voffB[i] = (unsigned)Rb * rowB + (unsigned)C * 2u; }
    const size_t kstepB = (size_t)(BK * 2);
    const size_t kstepA = (size_t)g.kstepA;
    const size_t hstepB = (size_t)HALF * rowB;
    const unsigned ldsw = (unsigned)wid * 1024u;
    const int aoff = lds_byte(wr * 64 + fr, fq * 8), boff = lds_byte(wc * 32 + fr, fq * 8);
#define PG8_SA(b, h) (((b) * 2 + (h)) * HTB)
#define PG8_SB(b, h) ((4 + (b) * 2 + (h)) * HTB)
#define PG8_STAGE(bufoff, gbase, voff) do { _Pragma("unroll") for (int _i = 0; _i < 2; ++_i) \
        __builtin_amdgcn_global_load_lds((const unsigned*)((const char*)(gbase) + (voff)[_i]), (PG8_LAS unsigned*)(lds + (bufoff) + ldsw + _i * 8192), 16, 0, 0); } while (0)
#define PG8_LDA(dst, b, h) do { _Pragma("unroll") for (int m = 0; m < 4; ++m) _Pragma("unroll") for (int k = 0; k < 2; ++k) dst[m][k] = *(const PG8_LAS bf16x8*)(lds + PG8_SA(b, h) + aoff + m * 2048 + k * 1024); } while (0)
#define PG8_LDB(dst, b, h) do { _Pragma("unroll") for (int n = 0; n < 2; ++n) _Pragma("unroll") for (int k = 0; k < 2; ++k) dst[n][k] = *(const PG8_LAS bf16x8*)(lds + PG8_SB(b, h) + boff + n * 2048 + k * 1024); } while (0)
#define PG8_MMA(ai, bj, At, Bt) do { __builtin_amdgcn_s_setprio(1); _Pragma("unroll") for (int m = 0; m < 4; ++m) _Pragma("unroll") for (int n = 0; n < 2; ++n) _Pragma("unroll") for (int k = 0; k < 2; ++k) \
        { if constexpr (I8) acc[ai][bj][m][n] = __builtin_amdgcn_mfma_i32_16x16x64_i8(__builtin_bit_cast(i32x4, Bt[n][k]), __builtin_bit_cast(i32x4, At[m][k]), acc[ai][bj][m][n], 0, 0, 0); \
          else acc[ai][bj][m][n] = __builtin_amdgcn_mfma_f32_16x16x32_bf16(Bt[n][k], At[m][k], acc[ai][bj][m][n], 0, 0, 0); } __builtin_amdgcn_s_setprio(0); } while (0)
#define PG8_WAIT_V(n) asm volatile("s_waitcnt vmcnt(" #n ")" ::: "memory")
#define PG8_WAIT_L(n) asm volatile("s_waitcnt lgkmcnt(" #n ")" ::: "memory")
#define PG8_BAR __builtin_amdgcn_s_barrier()
#define PG8_SCHED __builtin_amdgcn_sched_barrier(0)
    Unit cur, nxt; int ui = 0;
    if (!S.next(0, cur)) return;
    typedef typename AccSel<I8>::T AccT;
    AccT acc[2][2][4][2];
#pragma unroll
    for (int a = 0; a < 2; ++a)
#pragma unroll
        for (int b = 0; b < 2; ++b)
#pragma unroll
            for (int m = 0; m < 4; ++m)
#pragma unroll
                for (int n = 0; n < 2; ++n) acc[a][b][m][n] = AccT{};
    bf16x8 At[4][2], B0[2][2], B1[2][2];
    unsigned vA0[2], vA1[2], vN0[2], vN1[2];
#pragma unroll
    for (int i = 0; i < 2; ++i) { vA0[i] = S.arow(cur, Rr[i]) + (unsigned)Cc[i] * 2u; vA1[i] = S.arow(cur, HALF + Rr[i]) + (unsigned)Cc[i] * 2u; }
    const char* gA = (const char*)g.A; const char* cB = (const char*)g.Bt + cur.boff;
    if constexpr (has_prefetch<Epi>::value) E.prefetch(cur, 0, wid, lane);
    PG8_STAGE(PG8_SB(0, 0), cB, voffB); PG8_STAGE(PG8_SB(0, 1), cB + hstepB, voffB); PG8_STAGE(PG8_SA(0, 0), gA, vA0); PG8_STAGE(PG8_SA(0, 1), gA, vA1);
    if (wr == 1) PG8_BAR;
    PG8_WAIT_V(2); PG8_BAR;
    PG8_STAGE(PG8_SB(1, 0), cB + kstepB, voffB); PG8_STAGE(PG8_SA(1, 0), gA + kstepA, vA0); PG8_STAGE(PG8_SB(1, 1), cB + hstepB + kstepB, voffB);
    PG8_WAIT_V(6); PG8_BAR;
    for (;;) {
        const bool has_next = S.next(ui + 1, nxt);
        const char* nB = has_next ? (const char*)g.Bt + nxt.boff : cB;
#pragma unroll
        for (int i = 0; i < 2; ++i) { vN0[i] = has_next ? S.arow(nxt, Rr[i]) + (unsigned)Cc[i] * 2u : vA0[i]; vN1[i] = has_next ? S.arow(nxt, HALF + Rr[i]) + (unsigned)Cc[i] * 2u : vA1[i]; }
        for (int t = 0; t < nt; t += 2) {
            const bool last = (t == nt - 2);
            const char* a1 = gA + (size_t)(t + 1) * kstepA;
            const char* a2 = last ? gA : gA + (size_t)(t + 2) * kstepA; const char* b2 = last ? nB : cB + (size_t)(t + 2) * kstepB;
            const char* a3 = a2 + kstepA; const char* b3 = b2 + kstepB;
            unsigned o0[2], o1[2];
#pragma unroll
            for (int i = 0; i < 2; ++i) { o0[i] = last ? vN0[i] : vA0[i]; o1[i] = last ? vN1[i] : vA1[i]; }
            PG8_LDB(B0, 0, 0); PG8_LDB(B1, 0, 1); PG8_SCHED; PG8_LDA(At, 0, 0); PG8_STAGE(PG8_SA(1, 1), a1, vA1);
            PG8_WAIT_V(8); PG8_WAIT_L(0); PG8_BAR; PG8_MMA(0, 0, At, B0); PG8_MMA(0, 1, At, B1); PG8_BAR; PG8_SCHED;
            PG8_LDA(At, 0, 1); PG8_STAGE(PG8_SB(0, 0), b2, voffB); PG8_STAGE(PG8_SB(0, 1), b2 + hstepB, voffB); PG8_STAGE(PG8_SA(0, 0), a2, o0);
            PG8_WAIT_V(8); PG8_WAIT_L(0); PG8_BAR; PG8_MMA(1, 0, At, B0); PG8_MMA(1, 1, At, B1); PG8_BAR; PG8_SCHED;
            PG8_LDB(B0, 1, 0); PG8_LDB(B1, 1, 1); PG8_SCHED; PG8_LDA(At, 1, 0); PG8_STAGE(PG8_SA(0, 1), a2, o1);
            PG8_WAIT_V(8); PG8_WAIT_L(0); PG8_BAR; PG8_MMA(0, 0, At, B0); PG8_MMA(0, 1, At, B1); PG8_BAR; PG8_SCHED;
            PG8_LDA(At, 1, 1); PG8_STAGE(PG8_SB(1, 0), b3, voffB); PG8_STAGE(PG8_SB(1, 1), b3 + hstepB, voffB); PG8_STAGE(PG8_SA(1, 0), a3, o0);
            PG8_WAIT_V(8); PG8_WAIT_L(0); PG8_BAR; PG8_MMA(1, 0, At, B0); PG8_MMA(1, 1, At, B1); PG8_BAR; PG8_SCHED;
        }
        if constexpr (ALIGN_EPI) { if (wr == 0) PG8_BAR; }
        if constexpr (has_prefetch<Epi>::value) E.run(acc, cur, wr, wc, fr, fq, ui & 1); else E(acc, cur, wr, wc, fr, fq);
        if (!has_next) break;
#pragma unroll
        for (int a = 0; a < 2; ++a)
#pragma unroll
            for (int b = 0; b < 2; ++b)
#pragma unroll
                for (int m = 0; m < 4; ++m)
#pragma unroll
                    for (int n = 0; n < 2; ++n) acc[a][b][m][n] = AccT{};
        cur = nxt; cB = nB; ++ui;
        if constexpr (has_prefetch<Epi>::value) E.prefetch(cur, ui & 1, wid, lane);
#pragma unroll
        for (int i = 0; i < 2; ++i) { vA0[i] = vN0[i]; vA1[i] = vN1[i]; }
        if constexpr (ALIGN_EPI) { if (wr == 1) PG8_BAR; }
    }
    PG8_WAIT_V(0);
    if constexpr (!ALIGN_EPI) { if (wr == 0) PG8_BAR; }
    PG8_BAR;
#undef PG8_SA
#undef PG8_SB
#undef PG8_STAGE
#undef PG8_LDA
#undef PG8_LDB
#undef PG8_MMA
#undef PG8_WAIT_V
#undef PG8_WAIT_L
#undef PG8_BAR
#undef PG8_SCHED
}
}
namespace epi {
using pg8::f32x4; using pg8::u32x4; using pg8::Unit; using pg8::bf16_t; using pg8::cvt_pk_bf16;
constexpr int BM = 256, HALF = 128;
constexpr float NORM_EPS = 1e-6f;

__device__ __forceinline__ float row_rstd(const float* ssq, int row) {
    const f32x4* p = (const f32x4*)(ssq + (size_t)row * 16);
    const f32x4 a = p[0], b = p[1], c = p[2], d = p[3];
    const float s = ((a[0] + a[1]) + (a[2] + a[3])) + ((b[0] + b[1]) + (b[2] + b[3])) + ((c[0] + c[1]) + (c[2] + c[3])) + ((d[0] + d[1]) + (d[2] + d[3]));
    return __builtin_amdgcn_rsqf(s * (1.0f / 1024.0f) + NORM_EPS);
}
__device__ __forceinline__ void store8(bf16_t* p, const f32x4& v0, const f32x4& v1) {
    u32x4 w; w.x = cvt_pk_bf16(v0[0], v0[1]); w.y = cvt_pk_bf16(v0[2], v0[3]); w.z = cvt_pk_bf16(v1[0], v1[1]); w.w = cvt_pk_bf16(v1[2], v1[3]);
    *(u32x4*)p = w;
}

__device__ __forceinline__ void load8(const bf16_t* p, f32x4& v0, f32x4& v1) {
    const u32x4 w = *(const u32x4*)p;
    v0 = (f32x4){__uint_as_float(w.x << 16), __uint_as_float(w.x & 0xffff0000u), __uint_as_float(w.y << 16), __uint_as_float(w.y & 0xffff0000u)};
    v1 = (f32x4){__uint_as_float(w.z << 16), __uint_as_float(w.z & 0xffff0000u), __uint_as_float(w.w << 16), __uint_as_float(w.w & 0xffff0000u)};
}


typedef unsigned u32x2e __attribute__((ext_vector_type(2)));
typedef float f32x2 __attribute__((ext_vector_type(2)));
constexpr float RMAGIC = 12582912.0f;
__device__ __forceinline__ unsigned pack_magic4(float a, float b, float c, float d) {
    const unsigned p01 = __builtin_amdgcn_perm(__float_as_uint(b), __float_as_uint(a), 0x0c0c0400u), p23 = __builtin_amdgcn_perm(__float_as_uint(d), __float_as_uint(c), 0x04000c0cu);
    return p01 | p23;
}
__device__ __forceinline__ unsigned q4(const f32x4& v, float qs) {
    float q[4];
#pragma unroll
    for (int i = 0; i < 4; ++i) q[i] = __builtin_amdgcn_fmed3f(__builtin_fmaf(v[i], qs, RMAGIC), RMAGIC - 127.0f, RMAGIC + 127.0f);
    return pack_magic4(q[0], q[1], q[2], q[3]);
}
constexpr float PRED_GROW = 1.1f;
struct Pred { signed char* XQ; unsigned long long* ACC; const float* scl_in; float* scl_out; };
__device__ __forceinline__ void acc_add(unsigned long long* p, float ss) {
    const float ip = __builtin_floorf(ss);
    const unsigned long long v = ((unsigned long long)(unsigned)__builtin_fminf(ip, 4.0e9f) << 20) + (unsigned)((ss - ip) * 1048576.0f);
    __hip_atomic_fetch_add(p, v, __ATOMIC_RELAXED, __HIP_MEMORY_SCOPE_AGENT);
}
__device__ __forceinline__ float rstd4(const unsigned long long* acc, int row) { const unsigned long long v = acc[row];
    const float ssum = ((float)(unsigned)(v >> 32) * 4294967296.0f + (float)(unsigned)v) * (1.0f / 1048576.0f); return __builtin_amdgcn_rsqf(ssum * (1.0f / 1024.0f) + NORM_EPS); }

__device__ __forceinline__ float sumsq8(const f32x4& h0, const f32x4& h1) {
    return ((h0[0] * h0[0] + h0[1] * h0[1]) + (h0[2] * h0[2] + h0[3] * h0[3])) + ((h1[0] * h1[0] + h1[1] * h1[1]) + (h1[2] * h1[2] + h1[3] * h1[3]));
}

__device__ __forceinline__ void unpack8w(const u32x4& w, f32x4& v0, f32x4& v1) {
    v0 = (f32x4){__uint_as_float(w.x << 16), __uint_as_float(w.x & 0xffff0000u), __uint_as_float(w.y << 16), __uint_as_float(w.y & 0xffff0000u)};
    v1 = (f32x4){__uint_as_float(w.z << 16), __uint_as_float(w.z & 0xffff0000u), __uint_as_float(w.w << 16), __uint_as_float(w.w & 0xffff0000u)};
}
#define EPI_PRELOAD_H(ai) \
        u32x4 hw_[4][2]; \
        _Pragma("unroll") for (int m = 0; m < 4; ++m) _Pragma("unroll") for (int bj = 0; bj < 2; ++bj) \
            hw_[m][bj] = *(const u32x4*)(H + (size_t)(row0 + (ai) * HALF + m * 16) * 1024 + col0 + bj * HALF);

template <int KIND> struct EpiQKV {
    bf16_t* O; int ldc; const float* ssq; const float* qg; const float* kg; float qscale;
    __device__ __forceinline__ void operator()(const f32x4 (&acc)[2][2][4][2], const Unit& u, int wr, int wc, int fr, int fq) const {
        const float* gain = nullptr; float sc = 1.f; bool sig = false;
        if (KIND == 0) { const int t = u.pn >> 2; if (t == 0) { gain = qg; sc = qscale; } else if (t == 1) { gain = kg; } }
        else { if (u.pn < 4) { gain = qg; sc = qscale; } else if (u.pn == 6) { gain = kg + 64; } else if (u.pn == 8) { gain = kg + 128; } else if (u.pn == 10) { sig = true; } }
        f32x4 gv[2][2];
#pragma unroll
        for (int bj = 0; bj < 2; ++bj)
#pragma unroll
            for (int n = 0; n < 2; ++n) gv[bj][n] = gain ? *(const f32x4*)(gain + 32 * bj + 8 * fq + 4 * n) * sc : (f32x4){1.f, 1.f, 1.f, 1.f};
        const int row0 = u.pm * BM + wr * 64 + fr, col0 = u.pn * BM + wc * 64 + 8 * fq;
#pragma unroll
        for (int ai = 0; ai < 2; ++ai)
#pragma unroll
            for (int m = 0; m < 4; ++m) {
                const int row = row0 + ai * HALF + m * 16;
                const float rs = row_rstd(ssq, row);
                f32x4 v[2][2]; float ss = 0.f;
#pragma unroll
                for (int bj = 0; bj < 2; ++bj)
#pragma unroll
                    for (int n = 0; n < 2; ++n) { v[bj][n] = acc[ai][bj][m][n] * rs; const f32x4 x = v[bj][n]; ss += (x[0] * x[0] + x[1] * x[1]) + (x[2] * x[2] + x[3] * x[3]); }
                if (gain) {
                    ss += __shfl_xor(ss, 16); ss += __shfl_xor(ss, 32);
                    const float r = __builtin_amdgcn_rsqf(ss * (1.0f / 64.0f) + NORM_EPS);
#pragma unroll
                    for (int bj = 0; bj < 2; ++bj)
#pragma unroll
                        for (int n = 0; n < 2; ++n) v[bj][n] = v[bj][n] * r * gv[bj][n];
                }
                if (sig) {
#pragma unroll
                    for (int bj = 0; bj < 2; ++bj)
#pragma unroll
                        for (int n = 0; n < 2; ++n)
#pragma unroll
                            for (int i = 0; i < 4; ++i) v[bj][n][i] = __builtin_amdgcn_rcpf(1.0f + __expf(-v[bj][n][i]));
                }
                bf16_t* rowp = O + (size_t)row * ldc + col0;
#pragma unroll
                for (int bj = 0; bj < 2; ++bj) store8(rowp + 32 * bj, v[bj][0], v[bj][1]);
            }
    }
};

template <bool SLOT> struct EpiSwiGLU {
    bf16_t* O; int ldc; const float* rsrc;
    __device__ __forceinline__ void operator()(const f32x4 (&acc)[2][2][4][2], const Unit& u, int wr, int wc, int fr, int fq) const {
        const int row0 = u.pm * BM + wr * 64 + fr, col0 = u.pn * HALF + wc * 32 + 8 * fq;
#pragma unroll
        for (int ai = 0; ai < 2; ++ai)
#pragma unroll
            for (int m = 0; m < 4; ++m) {
                const int row = row0 + ai * HALF + m * 16;
                const float rs = SLOT ? rsrc[row] : row_rstd(rsrc, row);
                f32x4 o[2];
#pragma unroll
                for (int n = 0; n < 2; ++n)
#pragma unroll
                    for (int i = 0; i < 4; ++i) { const float gt = acc[ai][0][m][n][i] * rs, up = acc[ai][1][m][n][i] * rs; o[n][i] = gt * __builtin_amdgcn_rcpf(1.0f + __expf(-gt)) * up; }
                store8(O + (size_t)row * ldc + col0, o[0], o[1]);
            }
    }
};

struct EpiResid {
    float* H; bf16_t* XB; float* SSQ;
    __device__ __forceinline__ void operator()(const f32x4 (&acc)[2][2][4][2], const Unit& u, int wr, int wc, int fr, int fq) const {
        const int row0 = u.pm * BM + wr * 64 + fr, col0 = u.pn * BM + wc * 32 + 8 * fq;
#pragma unroll
        for (int ai = 0; ai < 2; ++ai)
#pragma unroll
            for (int m = 0; m < 4; ++m) {
                const int row = row0 + ai * HALF + m * 16; float ss = 0.f;
#pragma unroll
                for (int bj = 0; bj < 2; ++bj) {
                    float* hp = H + (size_t)row * 1024 + col0 + bj * HALF;
                    f32x4 h0 = *(const f32x4*)hp, h1 = *(const f32x4*)(hp + 4);
                    h0 = h0 + acc[ai][bj][m][0]; h1 = h1 + acc[ai][bj][m][1];
                    *(f32x4*)hp = h0; *(f32x4*)(hp + 4) = h1;
                    store8(XB + (size_t)row * 1024 + col0 + bj * HALF, h0, h1);
                    ss += (h0[0] * h0[0] + h0[1] * h0[1]) + (h0[2] * h0[2] + h0[3] * h0[3]) + (h1[0] * h1[0] + h1[1] * h1[1]) + (h1[2] * h1[2] + h1[3] * h1[3]);
                }
                ss += __shfl_xor(ss, 16); ss += __shfl_xor(ss, 32);
                if (fq == 0) SSQ[(size_t)row * 16 + u.pn * 4 + wc] = ss;
            }
    }
};

struct EpiPlain {
    bf16_t* O; int ldc;
    __device__ __forceinline__ void operator()(const f32x4 (&acc)[2][2][4][2], const Unit& u, int wr, int wc, int fr, int fq) const {
        const int row0 = u.pm * BM + wr * 64 + fr, col0 = u.pn * BM + wc * 32 + 8 * fq;
#pragma unroll
        for (int ai = 0; ai < 2; ++ai)
#pragma unroll
            for (int m = 0; m < 4; ++m) {
                const int row = row0 + ai * HALF + m * 16;
#pragma unroll
                for (int bj = 0; bj < 2; ++bj) store8(O + (size_t)row * ldc + col0 + bj * HALF, acc[ai][bj][m][0], acc[ai][bj][m][1]);
            }
    }
};

__device__ __forceinline__ float gelu_tanh(float x) {
    const float z = 0.7978845608028654f * (x + 0.044715f * x * x * x);
    const float t = 1.0f - 2.0f * __builtin_amdgcn_rcpf(1.0f + __expf(2.0f * z));
    return 0.5f * x * (1.0f + t);
}
struct EpiGelu {
    bf16_t* O; const float* cb;
    __device__ __forceinline__ void operator()(const f32x4 (&acc)[2][2][4][2], const Unit& u, int wr, int wc, int fr, int fq) const {
        const int row0 = u.pm * BM + wr * 64 + fr, col0 = wc * 32 + 8 * fq;
        bf16_t* base = O + (size_t)u.aux * 8192 * 256; const float* cbp = cb + u.aux * 256;
        f32x4 bv[2][2];
#pragma unroll
        for (int bj = 0; bj < 2; ++bj)
#pragma unroll
            for (int n = 0; n < 2; ++n) bv[bj][n] = *(const f32x4*)(cbp + col0 + bj * HALF + 4 * n);
#pragma unroll
        for (int ai = 0; ai < 2; ++ai)
#pragma unroll
            for (int m = 0; m < 4; ++m) {
                const int row = row0 + ai * HALF + m * 16;
#pragma unroll
                for (int bj = 0; bj < 2; ++bj) {
                    f32x4 v0 = acc[ai][bj][m][0] + bv[bj][0], v1 = acc[ai][bj][m][1] + bv[bj][1];
#pragma unroll
                    for (int i = 0; i < 4; ++i) { v0[i] = gelu_tanh(v0[i]); v1[i] = gelu_tanh(v1[i]); }
                    store8(base + (size_t)row * 256 + col0 + bj * HALF, v0, v1);
                }
            }
    }
};

template <bool PRED> struct EpiSwiGLU8 {
    signed char* O; int ldc; const float* ra; const float* sw; const float* hsc; const unsigned long long* ssq;
    __attribute__((address_space(3))) unsigned char* side0;
    static constexpr int SIDE = 5120;
    __device__ __forceinline__ void prefetch(const Unit& u, int side, int wid, int lane) const {
        if (wid == 0) {
            asm volatile("" : "+v"(lane));
            __attribute__((address_space(3))) unsigned char* sb = side0 + side * SIDE;
            __builtin_amdgcn_global_load_lds((const unsigned*)(sw + (size_t)u.aux * 7168 + u.pn * BM + lane * 4), (__attribute__((address_space(3))) unsigned*)sb, 16, 0, 0);
            __builtin_amdgcn_global_load_lds((const unsigned*)(ra + (size_t)u.pm * BM + lane * 4), (__attribute__((address_space(3))) unsigned*)(sb + 1024), 16, 0, 0);
            if (PRED) {
                __builtin_amdgcn_global_load_lds((const unsigned*)(ssq + (size_t)u.pm * BM + lane * 2), (__attribute__((address_space(3))) unsigned*)(sb + 2048), 16, 0, 0);
                __builtin_amdgcn_global_load_lds((const unsigned*)(ssq + (size_t)u.pm * BM + 128 + lane * 2), (__attribute__((address_space(3))) unsigned*)(sb + 3072), 16, 0, 0); }
            __builtin_amdgcn_global_load_lds((const unsigned*)(hsc + lane), (__attribute__((address_space(3))) unsigned*)(sb + 4096), 4, 0, 0);
        }
    }
    __device__ __forceinline__ void run(const pg8::i32x4 (&acc)[2][2][4][2], const Unit& u, int wr, int wc, int fr, int fq, int side) const {
        const __attribute__((address_space(3))) float* sl = (const __attribute__((address_space(3))) float*)(side0 + side * SIDE);
        const int row0 = u.pm * BM + wr * 64 + fr, col0 = u.pn * HALF + wc * 32 + 8 * fq;
        const int cb = wc * 32 + 8 * fq, rl0 = wr * 64 + fr;
        const float qs = sl[1024 + 2 * u.aux + 1];
        f32x4 c1[2], c2[2];
#pragma unroll
        for (int n = 0; n < 2; ++n) { const f32x4 sg = *(const __attribute__((address_space(3))) f32x4*)(sl + cb + 4 * n), su = *(const __attribute__((address_space(3))) f32x4*)(sl + HALF + cb + 4 * n); c1[n] = sg * (-1.4426950408889634f); c2[n] = sg * su * qs; }
        float rr_[2][4];
#pragma unroll
        for (int ai = 0; ai < 2; ++ai)
#pragma unroll
            for (int m = 0; m < 4; ++m) { const int rl = rl0 + ai * HALF + m * 16;
                if (PRED) { const unsigned long long v = ((const __attribute__((address_space(3))) unsigned long long*)(sl + 512))[rl];
                    const float ssum = ((float)(unsigned)(v >> 32) * 4294967296.0f + (float)(unsigned)v) * (1.0f / 1048576.0f);
                    rr_[ai][m] = sl[256 + rl] * (1.0f / 127.0f) * __builtin_amdgcn_rsqf(ssum * (1.0f / 1024.0f) + NORM_EPS); }
                else rr_[ai][m] = sl[256 + rl]; }
#pragma unroll
        for (int ai = 0; ai < 2; ++ai)
#pragma unroll
            for (int mp = 0; mp < 4; mp += 2) {
                unsigned wp[2][2];
#pragma unroll
                for (int mm = 0; mm < 2; ++mm) { const int m = mp + mm;
                const float r = rr_[ai][m], r2 = r * r;
                unsigned w[2];
#pragma unroll
                for (int n = 0; n < 2; ++n) { float qf[4];
#pragma unroll
                    for (int hh = 0; hh < 2; ++hh) {
                        const f32x2 ag = {(float)acc[ai][0][m][n][2 * hh], (float)acc[ai][0][m][n][2 * hh + 1]}, au = {(float)acc[ai][1][m][n][2 * hh], (float)acc[ai][1][m][n][2 * hh + 1]};
                        const f32x2 k1 = (f32x2){c1[n][2 * hh], c1[n][2 * hh + 1]} * r, k2 = (f32x2){c2[n][2 * hh], c2[n][2 * hh + 1]} * r2;
                        const f32x2 arg = ag * k1;
                        const f32x2 den = (f32x2){__builtin_amdgcn_exp2f(arg[0]), __builtin_amdgcn_exp2f(arg[1])} + 1.0f;
                        const f32x2 sg = {__builtin_amdgcn_rcpf(den[0]), __builtin_amdgcn_rcpf(den[1])};
                        const f32x2 t = (ag * au) * k2;
                        const f32x2 qv = __builtin_elementwise_fma(t, sg, (f32x2){RMAGIC, RMAGIC});
                        qf[2 * hh] = __builtin_amdgcn_fmed3f(qv[0], RMAGIC - 127.0f, RMAGIC + 127.0f); qf[2 * hh + 1] = __builtin_amdgcn_fmed3f(qv[1], RMAGIC - 127.0f, RMAGIC + 127.0f); }
                    w[n] = pack_magic4(qf[0], qf[1], qf[2], qf[3]); }
                wp[mm][0] = w[0]; wp[mm][1] = w[1]; }
                const auto s0 = __builtin_amdgcn_permlane16_swap(wp[0][0], wp[1][0], false, false);
                const auto s1 = __builtin_amdgcn_permlane16_swap(wp[0][1], wp[1][1], false, false);
                const int row = row0 + ai * HALF + (mp + (fq & 1)) * 16;
                *(u32x4*)(O + (size_t)row * ldc + col0 - 8 * (fq & 1)) = (u32x4){s0[0], s1[0], s0[1], s1[1]};
            }
    }
};
template <bool PRED> struct EpiResid8 {
    bf16_t* H; const float* swd; const float* hsc;
    Pred pr;
    __attribute__((address_space(3))) unsigned char* side0;
    static constexpr int SIDE = 5120;
    __device__ __forceinline__ void prefetch(const Unit& u, int side, int wid, int lane) const {
        if (wid == 0) {
            asm volatile("" : "+v"(lane));
            __attribute__((address_space(3))) unsigned char* sb = side0 + side * SIDE;
            __builtin_amdgcn_global_load_lds((const unsigned*)(swd + u.pn * BM + lane * 4), (__attribute__((address_space(3))) unsigned*)sb, 16, 0, 0);
            if (PRED) __builtin_amdgcn_global_load_lds((const unsigned*)(pr.scl_in + (size_t)u.pm * BM + lane * 4), (__attribute__((address_space(3))) unsigned*)(sb + 1024), 16, 0, 0);
            __builtin_amdgcn_global_load_lds((const unsigned*)(hsc + lane), (__attribute__((address_space(3))) unsigned*)(sb + 4096), 4, 0, 0);
        }
    }
    __device__ __forceinline__ void run(const pg8::i32x4 (&acc)[2][2][4][2], const Unit& u, int wr, int wc, int fr, int fq, int side) const {
        const __attribute__((address_space(3))) float* sl = (const __attribute__((address_space(3))) float*)(side0 + side * SIDE);
        const int row0 = u.pm * BM + wr * 64 + fr, col0 = u.pn * BM + wc * 32 + 8 * fq, cb = wc * 32 + 8 * fq, rl0 = wr * 64 + fr;
        const float hs = sl[1024] * (1.0f / 127.0f);
        f32x4 sc[2][2];
#pragma unroll
        for (int bj = 0; bj < 2; ++bj)
#pragma unroll
            for (int n = 0; n < 2; ++n) sc[bj][n] = *(const __attribute__((address_space(3))) f32x4*)(sl + cb + bj * HALF + 4 * n) * hs;
        float sin_[2][4];
        if (PRED) {
#pragma unroll
            for (int ai = 0; ai < 2; ++ai)
#pragma unroll
                for (int m = 0; m < 4; ++m) sin_[ai][m] = sl[256 + rl0 + ai * HALF + m * 16]; }
#pragma unroll
        for (int ai = 0; ai < 2; ++ai) {
        EPI_PRELOAD_H(ai)
#pragma unroll
            for (int m = 0; m < 4; ++m) {
                const int row = row0 + ai * HALF + m * 16;
                float rng = 0.f, qs = 0.f, ss = 0.f;
                if (PRED) { rng = __builtin_fmaxf(sin_[ai][m] * PRED_GROW, 1e-20f); qs = 127.0f * __builtin_amdgcn_rcpf(rng); }
#pragma unroll
                for (int bj = 0; bj < 2; ++bj) {
                    bf16_t* hp = H + (size_t)row * 1024 + col0 + bj * HALF;
                    f32x4 h0, h1; unpack8w(hw_[m][bj], h0, h1);
#pragma unroll
                    for (int i = 0; i < 4; ++i) { h0[i] += (float)acc[ai][bj][m][0][i] * sc[bj][0][i]; h1[i] += (float)acc[ai][bj][m][1][i] * sc[bj][1][i]; }
                    store8(hp, h0, h1);
                    if (PRED) { ss += sumsq8(h0, h1); *(u32x2e*)(pr.XQ + (size_t)row * 1024 + col0 + bj * HALF) = (u32x2e){q4(h0, qs), q4(h1, qs)}; }
                }
                if (PRED) { ss += __shfl_xor(ss, 16); ss += __shfl_xor(ss, 32);
                    if (fq == 0) { acc_add(pr.ACC + row, ss); if (u.pn == 0 && wc == 0) pr.scl_out[row] = rng; } }
            }
        }
    }
};
struct EpiPlain8 {
    bf16_t* O; int ldc; const float* swd; const float* hsc;
    __attribute__((address_space(3))) unsigned char* side0;
    static constexpr int SIDE = 5120;
    __device__ __forceinline__ void prefetch(const Unit& u, int side, int wid, int lane) const {
        if (wid == 0) {
            asm volatile("" : "+v"(lane));
            __attribute__((address_space(3))) unsigned char* sb = side0 + side * SIDE;
            __builtin_amdgcn_global_load_lds((const unsigned*)(swd + (size_t)u.aux * 1024 + u.pn * BM + lane * 4), (__attribute__((address_space(3))) unsigned*)sb, 16, 0, 0);
            __builtin_amdgcn_global_load_lds((const unsigned*)(hsc + lane), (__attribute__((address_space(3))) unsigned*)(sb + 4096), 4, 0, 0);
        }
    }
    __device__ __forceinline__ void run(const pg8::i32x4 (&acc)[2][2][4][2], const Unit& u, int wr, int wc, int fr, int fq, int side) const {
        const __attribute__((address_space(3))) float* sl = (const __attribute__((address_space(3))) float*)(side0 + side * SIDE);
        const int row0 = u.pm * BM + wr * 64 + fr, col0 = u.pn * BM + wc * 32 + 8 * fq, cb = wc * 32 + 8 * fq;
        const float hs = sl[1024 + 2 * u.aux] * (1.0f / 127.0f);
        f32x4 sc[2][2];
#pragma unroll
        for (int bj = 0; bj < 2; ++bj)
#pragma unroll
            for (int n = 0; n < 2; ++n) sc[bj][n] = *(const __attribute__((address_space(3))) f32x4*)(sl + cb + bj * HALF + 4 * n) * hs;
#pragma unroll
        for (int ai = 0; ai < 2; ++ai)
#pragma unroll
            for (int m = 0; m < 4; ++m) {
                const int row = row0 + ai * HALF + m * 16;
#pragma unroll
                for (int bj = 0; bj < 2; ++bj) { f32x4 v0, v1;
#pragma unroll
                    for (int i = 0; i < 4; ++i) { v0[i] = (float)acc[ai][bj][m][0][i] * sc[bj][0][i]; v1[i] = (float)acc[ai][bj][m][1][i] * sc[bj][1][i]; }
                    store8(O + (size_t)row * ldc + col0 + bj * HALF, v0, v1); }
            }
    }
};

template <int KIND, bool PRED> struct EpiQKV8 {
    bf16_t* O; int ldc; const float* ra; const float* sw; const float* qg; const float* kg; float qscale; const unsigned long long* ssq;
    __attribute__((address_space(3))) unsigned char* side0;
    static constexpr int SIDE = 5120;
    __device__ __forceinline__ const float* gain_of(const Unit& u, float& sc, bool& sig) const {
        const float* gain = nullptr; sc = 1.f; sig = false;
        if (KIND == 0) { const int t = u.pn >> 2; if (t == 0) { gain = qg; sc = qscale; } else if (t == 1) { gain = kg; } }
        else { if (u.pn < 4) { gain = qg; sc = qscale; } else if (u.pn == 6) { gain = kg + 64; } else if (u.pn == 8) { gain = kg + 128; } else if (u.pn == 10) { sig = true; } }
        return gain;
    }
    __device__ __forceinline__ void prefetch(const Unit& u, int side, int wid, int lane) const {
        if (wid == 0) {
            asm volatile("" : "+v"(lane));
            __attribute__((address_space(3))) unsigned char* sb = side0 + side * SIDE;
            __builtin_amdgcn_global_load_lds((const unsigned*)(sw + u.pn * BM + lane * 4), (__attribute__((address_space(3))) unsigned*)sb, 16, 0, 0);
            __builtin_amdgcn_global_load_lds((const unsigned*)(ra + (size_t)u.pm * BM + lane * 4), (__attribute__((address_space(3))) unsigned*)(sb + 1024), 16, 0, 0);
            if (PRED) {
                __builtin_amdgcn_global_load_lds((const unsigned*)(ssq + (size_t)u.pm * BM + lane * 2), (__attribute__((address_space(3))) unsigned*)(sb + 2048), 16, 0, 0);
                __builtin_amdgcn_global_load_lds((const unsigned*)(ssq + (size_t)u.pm * BM + 128 + lane * 2), (__attribute__((address_space(3))) unsigned*)(sb + 3072), 16, 0, 0); }
            float sc; bool sig; const float* gain = gain_of(u, sc, sig);
            if (gain) __builtin_amdgcn_global_load_lds((const unsigned*)(gain + lane), (__attribute__((address_space(3))) unsigned*)(sb + 4096), 4, 0, 0);
        }
    }
    __device__ __forceinline__ void run(const pg8::i32x4 (&acc)[2][2][4][2], const Unit& u, int wr, int wc, int fr, int fq, int side) const {
        const __attribute__((address_space(3))) float* sl = (const __attribute__((address_space(3))) float*)(side0 + side * SIDE);
        float sc; bool sig; const float* gain = gain_of(u, sc, sig);
        f32x4 gv[2][2], sv[2][2];
        const int cb = wc * 32 + 8 * fq, rl0 = wr * 64 + fr;
#pragma unroll
        for (int bj = 0; bj < 2; ++bj)
#pragma unroll
            for (int n = 0; n < 2; ++n) { gv[bj][n] = gain ? *(const __attribute__((address_space(3))) f32x4*)(sl + 1024 + 32 * bj + 8 * fq + 4 * n) * sc : (f32x4){1.f, 1.f, 1.f, 1.f}; sv[bj][n] = *(const __attribute__((address_space(3))) f32x4*)(sl + cb + bj * HALF + 4 * n); }
        const int row0 = u.pm * BM + wr * 64 + fr, col0 = u.pn * BM + wc * 64 + 8 * fq;
        float rr_[2][4];
#pragma unroll
        for (int ai = 0; ai < 2; ++ai)
#pragma unroll
            for (int m = 0; m < 4; ++m) { const int rl = rl0 + ai * HALF + m * 16;
                if (PRED) { const unsigned long long v = ((const __attribute__((address_space(3))) unsigned long long*)(sl + 512))[rl];
                    const float ssum = ((float)(unsigned)(v >> 32) * 4294967296.0f + (float)(unsigned)v) * (1.0f / 1048576.0f);
                    rr_[ai][m] = sl[256 + rl] * (1.0f / 127.0f) * __builtin_amdgcn_rsqf(ssum * (1.0f / 1024.0f) + NORM_EPS); }
                else rr_[ai][m] = sl[256 + rl]; }
#pragma unroll
        for (int ai = 0; ai < 2; ++ai)
#pragma unroll
            for (int m = 0; m < 4; ++m) {
                const int row = row0 + ai * HALF + m * 16;
                const float rs = rr_[ai][m];
                f32x4 v[2][2]; float ss = 0.f;
#pragma unroll
                for (int bj = 0; bj < 2; ++bj)
#pragma unroll
                    for (int n = 0; n < 2; ++n) {
#pragma unroll
                        for (int i = 0; i < 4; ++i) v[bj][n][i] = (float)acc[ai][bj][m][n][i] * (rs * sv[bj][n][i]);
                        const f32x4 x = v[bj][n]; ss += (x[0] * x[0] + x[1] * x[1]) + (x[2] * x[2] + x[3] * x[3]); }
                if (gain) {
                    ss += __shfl_xor(ss, 16); ss += __shfl_xor(ss, 32);
                    const float r = __builtin_amdgcn_rsqf(ss * (1.0f / 64.0f) + NORM_EPS);
#pragma unroll
                    for (int bj = 0; bj < 2; ++bj)
#pragma unroll
                        for (int n = 0; n < 2; ++n) v[bj][n] = v[bj][n] * r * gv[bj][n];
                }
                if (sig) {
#pragma unroll
                    for (int bj = 0; bj < 2; ++bj)
#pragma unroll
                        for (int n = 0; n < 2; ++n)
#pragma unroll
                            for (int i = 0; i < 4; ++i) v[bj][n][i] = __builtin_amdgcn_rcpf(1.0f + __expf(-v[bj][n][i]));
                }
                bf16_t* rowp = O + (size_t)row * ldc + col0;
#pragma unroll
                for (int bj = 0; bj < 2; ++bj) store8(rowp + 32 * bj, v[bj][0], v[bj][1]);
            }
    }
};
template <bool PRED> struct EpiResidLean {
    bf16_t* H;
    Pred pr;
    __device__ __forceinline__ void operator()(const f32x4 (&acc)[2][2][4][2], const Unit& u, int wr, int wc, int fr, int fq) const {
        const int row0 = u.pm * BM + wr * 64 + fr, col0 = u.pn * BM + wc * 32 + 8 * fq;
        float sin_[2][4];
        if (PRED) {
#pragma unroll
            for (int ai = 0; ai < 2; ++ai)
#pragma unroll
                for (int m = 0; m < 4; ++m) sin_[ai][m] = pr.scl_in[row0 + ai * HALF + m * 16]; }
#pragma unroll
        for (int ai = 0; ai < 2; ++ai) {
        EPI_PRELOAD_H(ai)
#pragma unroll
            for (int m = 0; m < 4; ++m) {
                const int row = row0 + ai * HALF + m * 16;
                float rng = 0.f, qs = 0.f, ss = 0.f;
                if (PRED) { rng = __builtin_fmaxf(sin_[ai][m] * PRED_GROW, 1e-20f); qs = 127.0f * __builtin_amdgcn_rcpf(rng); }
#pragma unroll
                for (int bj = 0; bj < 2; ++bj) {
                    bf16_t* hp = H + (size_t)row * 1024 + col0 + bj * HALF;
                    f32x4 h0, h1; unpack8w(hw_[m][bj], h0, h1);
                    h0 = h0 + acc[ai][bj][m][0]; h1 = h1 + acc[ai][bj][m][1];
                    store8(hp, h0, h1);
                    if (PRED) { ss += sumsq8(h0, h1); *(u32x2e*)(pr.XQ + (size_t)row * 1024 + col0 + bj * HALF) = (u32x2e){q4(h0, qs), q4(h1, qs)}; }
                }
                if (PRED) { ss += __shfl_xor(ss, 16); ss += __shfl_xor(ss, 32);
                    if (fq == 0) { acc_add(pr.ACC + row, ss); if (u.pn == 0 && wc == 0) pr.scl_out[row] = rng; } }
            }
        }
    }
};
template <bool PRED> struct EpiResidLean8 {
    bf16_t* H; const float* sw; float sa;
    Pred pr;
    __attribute__((address_space(3))) unsigned char* side0;
    static constexpr int SIDE = 5120;
    __device__ __forceinline__ void prefetch(const Unit& u, int side, int wid, int lane) const {
        if (wid == 0) {
            asm volatile("" : "+v"(lane));
            __attribute__((address_space(3))) unsigned char* sb = side0 + side * SIDE;
            __builtin_amdgcn_global_load_lds((const unsigned*)(sw + u.pn * BM + lane * 4), (__attribute__((address_space(3))) unsigned*)sb, 16, 0, 0);
            if (PRED) __builtin_amdgcn_global_load_lds((const unsigned*)(pr.scl_in + (size_t)u.pm * BM + lane * 4), (__attribute__((address_space(3))) unsigned*)(sb + 1024), 16, 0, 0);
        }
    }
    __device__ __forceinline__ void run(const pg8::i32x4 (&acc)[2][2][4][2], const Unit& u, int wr, int wc, int fr, int fq, int side) const {
        const __attribute__((address_space(3))) float* sl = (const __attribute__((address_space(3))) float*)(side0 + side * SIDE);
        const int row0 = u.pm * BM + wr * 64 + fr, col0 = u.pn * BM + wc * 32 + 8 * fq, cb = wc * 32 + 8 * fq, rl0 = wr * 64 + fr;
        f32x4 sc[2][2];
#pragma unroll
        for (int bj = 0; bj < 2; ++bj)
#pragma unroll
            for (int n = 0; n < 2; ++n) sc[bj][n] = *(const __attribute__((address_space(3))) f32x4*)(sl + cb + bj * HALF + 4 * n) * sa;
        float sin_[2][4];
        if (PRED) {
#pragma unroll
            for (int ai = 0; ai < 2; ++ai)
#pragma unroll
                for (int m = 0; m < 4; ++m) sin_[ai][m] = sl[256 + rl0 + ai * HALF + m * 16]; }
#pragma unroll
        for (int ai = 0; ai < 2; ++ai) {
        EPI_PRELOAD_H(ai)
#pragma unroll
            for (int m = 0; m < 4; ++m) {
                const int row = row0 + ai * HALF + m * 16;
                float rng = 0.f, qs = 0.f, ss = 0.f;
                if (PRED) { rng = __builtin_fmaxf(sin_[ai][m] * PRED_GROW, 1e-20f); qs = 127.0f * __builtin_amdgcn_rcpf(rng); }
#pragma unroll
                for (int bj = 0; bj < 2; ++bj) {
                    bf16_t* hp = H + (size_t)row * 1024 + col0 + bj * HALF;
                    f32x4 h0, h1; unpack8w(hw_[m][bj], h0, h1);
#pragma unroll
                    for (int i = 0; i < 4; ++i) { h0[i] += (float)acc[ai][bj][m][0][i] * sc[bj][0][i]; h1[i] += (float)acc[ai][bj][m][1][i] * sc[bj][1][i]; }
                    store8(hp, h0, h1);
                    if (PRED) { ss += sumsq8(h0, h1); *(u32x2e*)(pr.XQ + (size_t)row * 1024 + col0 + bj * HALF) = (u32x2e){q4(h0, qs), q4(h1, qs)}; }
                }
                if (PRED) { ss += __shfl_xor(ss, 16); ss += __shfl_xor(ss, 32);
                    if (fq == 0) { acc_add(pr.ACC + row, ss); if (u.pn == 0 && wc == 0) pr.scl_out[row] = rng; } }
            }
        }
    }
};
}
constexpr int NWAVES = 8;
constexpr int T = 32768, S = 2048, NB = 16, D = 1024, FF = 3584, NE = 8;
constexpr int NIN = 58;
constexpr size_t MiB = 1u << 20;
constexpr float LOG2E = 1.4426950408889634f;
constexpr float C2 = 0.125f * LOG2E;
constexpr int SLOT_CAP = 65536 + NE * 256;
constexpr size_t WS_CTL = 0, CTL_ZERO_BYTES = 2 * MiB;
constexpr size_t WS_SSQ = 1 * MiB;
constexpr size_t WS_ROUTE = 3 * MiB;
constexpr size_t WS_SLOT = 3 * MiB + 512 * 1024;
constexpr size_t WS_TOK = 4 * MiB;
constexpr size_t WS_RSS = 4 * MiB + 512 * 1024;
constexpr size_t WS_CNT = 5 * MiB;
constexpr size_t WS_META = 5 * MiB + 16 * 1024;
constexpr size_t WS_RST = 5 * MiB + 64 * 1024;
constexpr size_t WS_KM = 6 * MiB;
constexpr size_t WS_SEL = 6 * MiB + 512 * 1024;
constexpr size_t WS_CB = 7 * MiB;
constexpr size_t WS_KCMP = 8 * MiB, WS_VCMP = 9 * MiB;
constexpr size_t WS_HID = 10 * MiB;
constexpr size_t WS_XB = 32 * MiB;
constexpr size_t WS_WIN = 96 * MiB, WS_WOUT = 102 * MiB, WS_CW1 = 104 * MiB, WS_WFF = 106 * MiB;
constexpr size_t WFF_GU_BYTES = (size_t)7168 * 1024 * 2, WFF_DN_BYTES = (size_t)1024 * 3584 * 2;
constexpr size_t WS_BIG = 276 * MiB;
constexpr size_t WS_QKV = WS_BIG;
constexpr size_t WS_AO = WS_BIG + 192 * MiB;
constexpr size_t WS_TMP = WS_BIG + 256 * MiB;
constexpr size_t WS_HB = WS_BIG;
constexpr size_t WS_Y = 740 * MiB;
constexpr size_t WS_XQ = 872 * MiB;
constexpr size_t WS_END = 904 * MiB;
constexpr size_t WS_XQS = 512 * MiB;
static_assert(WS_BIG + (size_t)SLOT_CAP * FF <= WS_XQS && WS_XQS + (size_t)SLOT_CAP * 1024 <= 740 * MiB, "slot-ordered rows fit");
constexpr size_t WS_SW = 18 * MiB;
constexpr size_t WS_SWD = 18 * MiB + 229376, WS_HSC = 18 * MiB + 229376 + 32768;
constexpr size_t WS_SWI = 18 * MiB + 327680;
constexpr size_t CT_CMAXW0 = 720896, CT_CMAXW1 = 737280, CT_CMAXW2 = 753664, CT_CMAXW3 = 770048;
constexpr size_t WS_SWO = 18 * MiB + 344064;
constexpr size_t CT_CMAXO0 = 667648, CT_CMAXO3 = 671744;
constexpr size_t CT_CMAXD0 = 589824, CT_CMAXD1 = 593920, CT_CMAXD2 = 626688, CT_CMAXD3 = 630784;
constexpr size_t CT_CMAX0 = 65536, CT_CMAX1 = 98304, CT_CMAX2 = 327680, CT_CMAX3 = 360448;
static_assert(WS_WFF + NE * (WFF_GU_BYTES + WFF_DN_BYTES) <= WS_BIG, "weights fit");
static_assert(WS_HB + (size_t)SLOT_CAP * FF * 2 <= WS_Y && WS_Y + (size_t)SLOT_CAP * 1024 * 2 <= WS_END, "moe buffers fit");
static_assert(WS_TMP + (size_t)T * 1024 * 4 <= WS_Y, "tmp fits");
constexpr int CW_BAR = 4096;
constexpr int RING_BYTES = 131072;
constexpr int MISC_OFF = RING_BYTES + 320;
constexpr int LDS_BYTES = 147456;

#define GAS __attribute__((address_space(1)))
#define LAS __attribute__((address_space(3)))
typedef unsigned short bf16;
typedef unsigned v4u __attribute__((ext_vector_type(4)));
typedef unsigned v2u __attribute__((ext_vector_type(2)));
typedef float f32x4 __attribute__((ext_vector_type(4)));
typedef GAS unsigned gu32;
#define RLX_AGENT __ATOMIC_RELAXED, __HIP_MEMORY_SCOPE_AGENT
__device__ __forceinline__ unsigned pk2(float lo, float hi) { return pg8::cvt_pk_bf16(lo, hi); }
__device__ __forceinline__ float bf_lo(unsigned w) { return __uint_as_float(w << 16); }
__device__ __forceinline__ float bf_hi(unsigned w) { return __uint_as_float(w & 0xffff0000u); }
__device__ __forceinline__ float bf1(bf16 v) { return __uint_as_float((unsigned)v << 16); }
__device__ __forceinline__ float wave_sum(float v) {
#pragma unroll
    for (int o = 1; o < 64; o <<= 1) v += __shfl_xor(v, o);
    return v;
}
#define XB_TMO      128
#define XB_XCNT(j)  (256  + 64 * (j))
#define XB_XSUB(j)  (1280 + 64 * (j))
#define XB_XGEN(j)  (2304 + 64 * (j))
#define XB_TOP      3328
#define XB_TOPGEN   3392
#define XCD_BAR_WORDS 3456
#define XB_SPIN_CAP (1u << 18)

__device__ __forceinline__ unsigned xb_ld(unsigned* p)              { return __hip_atomic_load(p, __ATOMIC_RELAXED, __HIP_MEMORY_SCOPE_AGENT); }
__device__ __forceinline__ unsigned xb_add(unsigned* p, unsigned v) { return __hip_atomic_fetch_add(p, v, __ATOMIC_RELAXED, __HIP_MEMORY_SCOPE_AGENT); }
__device__ __forceinline__ unsigned xb_xcc_id() { return (unsigned)__builtin_amdgcn_s_getreg((3 << 11) | 20) & 0xFu; }
#define XB_SPIN(cond, bar) do { unsigned _sp = 0; while (cond) { __builtin_amdgcn_s_sleep(1); \
    if ((++_sp & 255u) == 0u) { if (xb_ld(&(bar)[XB_TMO])) break; if (_sp > XB_SPIN_CAP) { atomicAdd(&(bar)[XB_TMO], 1u); break; } } } } while (0)

struct XcdBarrier {
    unsigned* bar; unsigned x;
    volatile LAS unsigned* st;
};

__device__ __forceinline__ XcdBarrier xcd_barrier_post(unsigned* bar, volatile LAS unsigned* st) {
    XcdBarrier b; b.bar = bar; b.x = xb_xcc_id(); b.st = st;
    if (threadIdx.x == 0) (void)xb_add(&bar[XB_XCNT(b.x)], 1u);
    return b;
}
__device__ __forceinline__ void xcd_barrier_complete(unsigned* bar, unsigned x, unsigned& nloc, unsigned& nx) {
    const unsigned G = gridDim.x * gridDim.y * gridDim.z;
    unsigned sum, cnt, mine, sp = 0u;
    for (;;) {
        sum = 0u; cnt = 0u; mine = 0u;
#pragma unroll
        for (unsigned j = 0; j < 16; ++j) { const unsigned c = xb_ld(&bar[XB_XCNT(j)]); sum += c; cnt += (c > 0u) ? 1u : 0u; mine = (j == x) ? c : mine; }
        if (sum == G) break;
        __builtin_amdgcn_s_sleep(1);
        if ((++sp & 255u) == 0u) { if (xb_ld(&bar[XB_TMO])) break; if (sp > XB_SPIN_CAP) { atomicAdd(&bar[XB_TMO], 1u); break; } }
    }
    nloc = mine > 0u ? mine : 1u; nx = cnt > 0u ? cnt : 1u;
}

__device__ __forceinline__ void xcd_barrier(const XcdBarrier& b) {
    asm volatile("s_waitcnt vmcnt(0)" ::: "memory");
    __syncthreads();
    if (threadIdx.x == 0) {
        unsigned* bar = b.bar;
        __builtin_amdgcn_s_waitcnt(0);
        unsigned nloc = b.st[0], nx = b.st[1];
        if (nloc == 0u) { xcd_barrier_complete(bar, b.x, nloc, nx); b.st[0] = nloc; b.st[1] = nx; }
        const unsigned old = xb_add(&bar[XB_XSUB(b.x)], 1u);
        const unsigned gen = old / nloc;
        if (old + 1u == (gen + 1u) * nloc) {
            __builtin_amdgcn_fence(__ATOMIC_RELEASE, "agent");
            asm volatile("s_waitcnt vmcnt(0)" ::: "memory");
            const unsigned og = xb_add(&bar[XB_TOP], 1u);
            const unsigned tg = og / nx;
            if (og + 1u == (tg + 1u) * nx) xb_add(&bar[XB_TOPGEN], 1u);
            else XB_SPIN(xb_ld(&bar[XB_TOPGEN]) == tg, bar);
            __builtin_amdgcn_fence(__ATOMIC_ACQUIRE, "agent");
            xb_add(&bar[XB_XGEN(b.x)], 1u);
            asm volatile("s_waitcnt vmcnt(0)" ::: "memory");
        } else {
            XB_SPIN(xb_ld(&bar[XB_XGEN(b.x)]) == gen, bar);
            __builtin_amdgcn_fence(__ATOMIC_ACQUIRE, "agent");
            asm volatile("s_waitcnt vmcnt(0)" ::: "memory");
        }
    }
    __syncthreads();
}
struct Ctx { int tid, lane, wave, bid, G, gw, NGW; LAS unsigned char* lds; };

__device__ __forceinline__ void unpack8(const v4u w, f32x4& a, f32x4& b) { a = (f32x4){bf_lo(w.x), bf_hi(w.x), bf_lo(w.y), bf_hi(w.y)}; b = (f32x4){bf_lo(w.z), bf_hi(w.z), bf_lo(w.w), bf_hi(w.w)}; }
__device__ __forceinline__ void load_hrow(const bf16* hrow, f32x4 (&v)[4], int lane) {
    const v4u* p = (const v4u*)hrow + lane;
    const v4u w0 = p[0], w1 = p[64];
    unpack8(w0, v[0], v[1]); unpack8(w1, v[2], v[3]);
}
__device__ __forceinline__ void store_hrow(bf16* hrow, const f32x4 (&v)[4], int lane) {
    v4u* p = (v4u*)hrow + lane;
    v4u w0, w1;
    w0.x = pk2(v[0][0], v[0][1]); w0.y = pk2(v[0][2], v[0][3]); w0.z = pk2(v[1][0], v[1][1]); w0.w = pk2(v[1][2], v[1][3]);
    w1.x = pk2(v[2][0], v[2][1]); w1.y = pk2(v[2][2], v[2][3]); w1.z = pk2(v[3][0], v[3][1]); w1.w = pk2(v[3][2], v[3][3]);
    p[0] = w0; p[64] = w1;
}
__device__ __forceinline__ void load_frow(const float* row, f32x4 (&v)[4], int lane) {
    const f32x4* p = (const f32x4*)row + 2 * lane;
    v[0] = __builtin_nontemporal_load(p); v[1] = __builtin_nontemporal_load(p + 1); v[2] = __builtin_nontemporal_load(p + 128); v[3] = __builtin_nontemporal_load(p + 129);
}
__device__ __forceinline__ void store_frow(float* row, const f32x4 (&v)[4], int lane) {
    f32x4* p = (f32x4*)row + 2 * lane;
    __builtin_nontemporal_store(v[0], p); __builtin_nontemporal_store(v[1], p + 1); __builtin_nontemporal_store(v[2], p + 128); __builtin_nontemporal_store(v[3], p + 129);
}
__device__ __forceinline__ void quant_row(const f32x4 (&v)[4], float amax, float ss, signed char* xq_row, float* ra, int lane);
__device__ __forceinline__ float wave_max(float v);
__device__ __forceinline__ void ph_prep(const Ctx& c, const float* x, bf16* H, signed char* XQ, float* RA) {
    for (int m0 = c.gw * 4; m0 < T; m0 += c.NGW * 4) {
        f32x4 v[4][4];
#pragma unroll
        for (int u = 0; u < 4; ++u) load_frow(x + (size_t)(m0 + u) * D, v[u], c.lane);
#pragma unroll
        for (int u = 0; u < 4; ++u) { const int m = m0 + u; float s = 0.f, am = 0.f;
#pragma unroll
            for (int j = 0; j < 4; ++j) { s += (v[u][j][0] * v[u][j][0] + v[u][j][1] * v[u][j][1]) + (v[u][j][2] * v[u][j][2] + v[u][j][3] * v[u][j][3]);
                am = __builtin_fmaxf(am, __builtin_fmaxf(__builtin_fmaxf(__builtin_fabsf(v[u][j][0]), __builtin_fabsf(v[u][j][1])), __builtin_fmaxf(__builtin_fabsf(v[u][j][2]), __builtin_fabsf(v[u][j][3])))); }
            s = wave_sum(s); am = wave_max(am);
            store_hrow(H + (size_t)m * D, v[u], c.lane);
            quant_row(v[u], am, s, XQ + (size_t)m * D, RA + m, c.lane); }
    }
}

__device__ __forceinline__ int dest_row(int n0, int mode) {
    if (mode == 1) { const int blk = n0 & ~255, np = n0 & 255; return blk + 128 * ((np >> 5) & 1) + 32 * (np >> 6); }
    if (mode == 2) return 256 * (n0 >> 7) + (n0 & 127);
    if (mode == 3) return 256 * (n0 >> 7) + 128 + (n0 & 127);
    return n0;
}
__device__ __forceinline__ void cv_item(const float* W, int ldw, int nvalid, const float* kscale, bf16* WT, int K, int k0, int n0, int drow, LAS float* scr, int lane) {
    const int n = n0 + (lane & 31); const bool ok = n < nvalid;
    const float* src = W + (size_t)(k0 + (lane >> 5)) * ldw + n;
    float v[32];
#pragma unroll
    for (int i = 0; i < 32; ++i) v[i] = ok ? src[(size_t)(2 * i) * ldw] : 0.f;
    if (kscale) {
#pragma unroll
        for (int i = 0; i < 32; ++i) v[i] *= kscale[k0 + 2 * i + (lane >> 5)];
    }
#pragma unroll
    for (int i = 0; i < 32; ++i) scr[(2 * i + (lane >> 5)) * 33 + (lane & 31)] = v[i];
    asm volatile("s_waitcnt lgkmcnt(0)" ::: "memory");
    const int ch = lane & 7;
#pragma unroll
    for (int j = 0; j < 4; ++j) { const int nn = (lane >> 3) + 8 * j; const LAS float* sp = scr + (8 * ch) * 33 + nn;
        v4u o; o.x = pk2(sp[0 * 33], sp[1 * 33]); o.y = pk2(sp[2 * 33], sp[3 * 33]); o.z = pk2(sp[4 * 33], sp[5 * 33]); o.w = pk2(sp[6 * 33], sp[7 * 33]);
        *(v4u*)(WT + (size_t)(drow + nn) * K + k0 + 8 * ch) = o; }
    asm volatile("s_waitcnt lgkmcnt(0)" ::: "memory");
}
__device__ __forceinline__ void cv_matrix(const Ctx& c, const float* W, int K, int ldw, int nvalid, int npad, const float* kscale, bf16* WT, int mode, int& rot) {
    LAS float* scr = (LAS float*)(c.lds + c.wave * 16384);
    const int nblk = npad / 32, nitems = (K / 64) * nblk;
    int first = c.gw - rot; if (first < 0) first += c.NGW;
    for (int it = first; it < nitems; it += c.NGW) { const int kb = it / nblk, nb = it % nblk; cv_item(W, ldw, nvalid, kscale, WT, K, 64 * kb, 32 * nb, dest_row(32 * nb, mode), scr, c.lane); }
    rot = (rot + nitems) % c.NGW;
}
__device__ __forceinline__ void cv_attn_weights(const Ctx& c, const float* w_in, int n_in_cols, int n_in_pad, const float* norm_mix, const float* w_out, bf16* WIN, bf16* WOUT, int& rot) {
    cv_matrix(c, w_in, 1024, n_in_cols, n_in_cols, n_in_pad, norm_mix, WIN, 1, rot);
    cv_matrix(c, w_out, 1024, 1024, 1024, 1024, nullptr, WOUT, 0, rot);
}
__device__ __forceinline__ void cv_ffn_weights(const Ctx& c, const float* wg, const float* wu, const float* wd, const float* norm_ffn, bf16* WFF, int nexp, int& rot) {
    for (int e = 0; e < nexp; ++e) {
        bf16* gu = WFF + (size_t)e * (7168 * 1024); bf16* dn = WFF + (size_t)nexp * (7168 * 1024) + (size_t)e * (1024 * 3584);
        cv_matrix(c, wg + (size_t)e * 1024 * FF, 1024, FF, FF, FF, norm_ffn, gu, 2, rot);
        cv_matrix(c, wu + (size_t)e * 1024 * FF, 1024, FF, FF, FF, norm_ffn, gu, 3, rot);
        cv_matrix(c, wd + (size_t)e * FF * 1024, FF, 1024, 1024, 1024, nullptr, dn, 0, rot);
    }
}


__device__ __forceinline__ float wave_max(float v) {
#pragma unroll
    for (int o = 1; o < 64; o <<= 1) v = __builtin_fmaxf(v, __shfl_xor(v, o));
    return v;
}
__device__ __forceinline__ void cvq_max_item(const float* W, int ldw, int nvalid, const float* kscale, int* CMAX, int k0, int n0, int drow0, int drow1, int lane) {
    const int rsub = lane >> 4, ch = lane & 15, n = n0 + 4 * ch; const bool ok = n < nvalid;
    const float* src = W + (size_t)(k0 + rsub) * ldw + n;
    f32x4 v[16];
#pragma unroll
    for (int j = 0; j < 16; ++j) v[j] = ok ? __builtin_nontemporal_load((const f32x4*)(src + (size_t)(4 * j) * ldw)) : (f32x4){0.f, 0.f, 0.f, 0.f};
    f32x4 m = {0.f, 0.f, 0.f, 0.f};
#pragma unroll
    for (int j = 0; j < 16; ++j) { const float ks = kscale ? kscale[k0 + 4 * j + rsub] : 1.0f;
#pragma unroll
        for (int i = 0; i < 4; ++i) m[i] = __builtin_fmaxf(m[i], __builtin_fabsf(v[j][i] * ks)); }
    const int dr = ((ch >> 3) ? drow1 : drow0) + ((4 * ch) & 31);
#pragma unroll
    for (int i = 0; i < 4; ++i) { float x = m[i]; x = __builtin_fmaxf(x, __shfl_xor(x, 16)); x = __builtin_fmaxf(x, __shfl_xor(x, 32)); if (rsub == 0) atomicMax(CMAX + dr + i, (int)__float_as_uint(x)); }
}
__device__ __forceinline__ void cvq_quant_item(const float* W, int ldw, int nvalid, const float* kscale, const int* CMAX, float* SW, signed char* WQ, int K, int k0, int n0, int drow0, int drow1, LAS unsigned char* scr, int lane, float rng) {
    const int rsub = lane >> 4, ch = lane & 15, n = n0 + 4 * ch; const bool ok = n < nvalid;
    const float* src = W + (size_t)(k0 + rsub) * ldw + n;
    f32x4 v[16];
#pragma unroll
    for (int j = 0; j < 16; ++j) v[j] = ok ? __builtin_nontemporal_load((const f32x4*)(src + (size_t)(4 * j) * ldw)) : (f32x4){0.f, 0.f, 0.f, 0.f};
    const int dr = ((ch >> 3) ? drow1 : drow0) + ((4 * ch) & 31);
    f32x4 inv;
#pragma unroll
    for (int i = 0; i < 4; ++i) { const float cm = rng * __uint_as_float((unsigned)CMAX[dr + i]); inv[i] = cm > 0.f ? 127.0f / cm : 0.f; if (k0 == 0 && rsub == 0) SW[dr + i] = cm * (1.0f / 127.0f); }
    asm volatile("" ::: "memory");
#pragma unroll
    for (int j = 0; j < 16; ++j) { const int kk = 4 * j + rsub; const float ks = kscale ? kscale[k0 + kk] : 1.0f;
#pragma unroll
        for (int i = 0; i < 4; ++i) { int q = (int)__builtin_rintf(v[j][i] * ks * inv[i]); q = q > 127 ? 127 : (q < -127 ? -127 : q); scr[(4 * ch + i) * 80 + kk] = (unsigned char)q; } }
    asm volatile("s_waitcnt lgkmcnt(0)" ::: "memory");
#pragma unroll
    for (int st = 0; st < 4; ++st) { const int r = st * 16 + (lane >> 2), c4 = lane & 3;
        const v4u x = *(const LAS v4u*)(scr + r * 80 + c4 * 16);
        const int drw = ((r >> 5) ? drow1 : drow0) + (r & 31);
        __builtin_nontemporal_store(x, (v4u*)(WQ + (size_t)drw * K + k0 + c4 * 16)); }
    asm volatile("s_waitcnt lgkmcnt(0)" ::: "memory");
}
__device__ __forceinline__ void cvq_matrix(const Ctx& c, const float* W, int K, int ldw, int N, int nvalid, const float* kscale, signed char* WQ, int* CMAX, float* SW, int mode, int pass, int& rot, bool full = false) {
    LAS unsigned char* scr = (LAS unsigned char*)(c.lds + c.wave * 16384);
    const int nblk = N / 64, nitems = (K / 64) * nblk;
    int first = c.gw - rot; if (first < 0) first += c.NGW;
    if (pass == 1) {
        const int kstep = full ? 64 : 512; const int nit1 = (K / kstep) * nblk;
        for (int it = first; it < nit1; it += c.NGW) { const int kb = it / nblk, nb = it % nblk; cvq_max_item(W, ldw, nvalid, kscale, CMAX, kstep * kb, 64 * nb, dest_row(64 * nb, mode), dest_row(64 * nb + 32, mode), c.lane); }
        rot = (rot + nit1) % c.NGW;
        return;
    }
    for (int it = first; it < nitems; it += c.NGW) { const int kb = it / nblk, nb = it % nblk;
        cvq_quant_item(W, ldw, nvalid, kscale, CMAX, SW, WQ, K, 64 * kb, 64 * nb, dest_row(64 * nb, mode), dest_row(64 * nb + 32, mode), scr, c.lane, full ? 1.0f : 1.3f); }
    rot = (rot + nitems) % c.NGW;
}
__device__ __forceinline__ void cvq_ffn(const Ctx& c, const float* wg, const float* wu, const float* wd, const float* norm_ffn, unsigned char* WFF8, int* CMAX, int* CMAXD, float* SW, float* SWD, int nexp, int pass, int& rot) {
    for (int e = 0; e < nexp; ++e) {
        signed char* gu = (signed char*)WFF8 + (size_t)e * 7168 * 1024; signed char* dn = (signed char*)WFF8 + (size_t)nexp * 7168 * 1024 + (size_t)e * 1024 * 3584;
        cvq_matrix(c, wg + (size_t)e * 1024 * FF, 1024, FF, FF, FF, norm_ffn, gu, CMAX + e * 7168, SW + e * 7168, 2, pass, rot);
        cvq_matrix(c, wu + (size_t)e * 1024 * FF, 1024, FF, FF, FF, norm_ffn, gu, CMAX + e * 7168, SW + e * 7168, 3, pass, rot);
        cvq_matrix(c, wd + (size_t)e * FF * 1024, FF, 1024, 1024, 1024, nullptr, dn, CMAXD + e * 1024, SWD + e * 1024, 0, pass, rot);
    }
}
__device__ __forceinline__ void ph_hidden_scale(const Ctx& c, const int* CMAX, float* HSC, int nexp) {
    if (c.gw < nexp) {
        const int* cm = CMAX + c.gw * 7168; float sg = 0.f, su = 0.f;
        for (int i = c.lane; i < 7168; i += 64) { const float v = __uint_as_float((unsigned)cm[i]); if ((i >> 7) & 1) su += v; else sg += v; }
        sg = wave_sum(sg) * (1.0f / 3584.0f); su = wave_sum(su) * (1.0f / 3584.0f);
        float clip = 8.0f * (sg * (1.0f / 0.0875f)) * (su * (1.0f / 0.0875f));
        clip = clip > 1e-20f ? clip : 1e-20f;
        if (c.lane == 0) { HSC[2 * c.gw] = clip; HSC[2 * c.gw + 1] = 127.0f / clip; }
    }
}
__device__ __forceinline__ void quant_row(const f32x4 (&v)[4], float amax, float ss, signed char* xq_row, float* ra, int lane) {
    const float rs = __builtin_amdgcn_rsqf(ss * (1.0f / 1024.0f) + 1e-6f);
    const float sc = amax > 0.f ? 127.0f / amax : 0.f;
    unsigned w[4];
#pragma unroll
    for (int j = 0; j < 4; ++j) { float qf[4];
#pragma unroll
        for (int i = 0; i < 4; ++i) qf[i] = __builtin_amdgcn_fmed3f(__builtin_fmaf(v[j][i], sc, epi::RMAGIC), epi::RMAGIC - 127.0f, epi::RMAGIC + 127.0f);
        w[j] = epi::pack_magic4(qf[0], qf[1], qf[2], qf[3]); }
    v2u* p = (v2u*)xq_row + lane;
    p[0] = (v2u){w[0], w[1]}; p[64] = (v2u){w[2], w[3]};
    if (lane == 0) { *ra = amax * (1.0f / 127.0f) * rs; ra[T] = amax; }
}
__device__ __forceinline__ void ph_quant_rows(const Ctx& c, const bf16* H, signed char* XQ, float* RA) {
    for (int m0 = c.gw * 4; m0 < T; m0 += c.NGW * 4) {
        f32x4 v[4][4];
#pragma unroll
        for (int u = 0; u < 4; ++u) load_hrow(H + (size_t)(m0 + u) * D, v[u], c.lane);
#pragma unroll
        for (int u = 0; u < 4; ++u) { float ss = 0.f, am = 0.f;
#pragma unroll
            for (int j = 0; j < 4; ++j) { ss += (v[u][j][0] * v[u][j][0] + v[u][j][1] * v[u][j][1]) + (v[u][j][2] * v[u][j][2] + v[u][j][3] * v[u][j][3]);
                am = __builtin_fmaxf(am, __builtin_fmaxf(__builtin_fmaxf(__builtin_fabsf(v[u][j][0]), __builtin_fabsf(v[u][j][1])), __builtin_fmaxf(__builtin_fabsf(v[u][j][2]), __builtin_fabsf(v[u][j][3])))); }
            ss = wave_sum(ss); am = wave_max(am);
            quant_row(v[u], am, ss, XQ + (size_t)(m0 + u) * D, RA + m0 + u, c.lane); }
    }
}

__device__ __forceinline__ int rel_bucket(int d) {
    if (d < 16) return d;
    int b = 16;
    b += (d >= 21); b += (d >= 27); b += (d >= 35); b += (d >= 46); b += (d >= 59); b += (d >= 77); b += (d >= 99); b += (d >= 128);
    b += (d >= 166); b += (d >= 216); b += (d >= 280); b += (d >= 363); b += (d >= 470); b += (d >= 609); b += (d >= 790);
    return b;
}
__device__ __forceinline__ void build_bias_tbl(LAS float* tbl, const float* rel_bias, int col, int tid) {
    for (int d = tid; d < 2048; d += 512) tbl[d] = rel_bias[rel_bucket(d) * 16 + col] * LOG2E;
}

template <bool HAS_BIAS, class Vis>
__device__ __forceinline__ void nv_attn_core(LAS float* Ks, LAS float* Vs, const LAS float* bias_d, const float (&q)[64], float (&o)[64], float& l_out,
                                             const bf16* Kg, int kpitch, const bf16* Vg, int vpitch, int t_lo, int t_hi, int qpos, int tid, Vis vis) {
    float m = -3.0e38f, l = 0.f;
#pragma unroll
    for (int d = 0; d < 64; ++d) o[d] = 0.f;
    const int srow = tid >> 3, sch = tid & 7;
    for (int t = t_lo; t < t_hi; ++t) {
        __syncthreads();
        { const v4u kw = *(const v4u*)(Kg + (size_t)(t * 64 + srow) * kpitch + sch * 8), vw = *(const v4u*)(Vg + (size_t)(t * 64 + srow) * vpitch + sch * 8);
          LAS f32x4* kd = (LAS f32x4*)(Ks + srow * 64 + sch * 8); LAS f32x4* vd = (LAS f32x4*)(Vs + srow * 64 + sch * 8);
          kd[0] = (f32x4){bf_lo(kw.x), bf_hi(kw.x), bf_lo(kw.y), bf_hi(kw.y)}; kd[1] = (f32x4){bf_lo(kw.z), bf_hi(kw.z), bf_lo(kw.w), bf_hi(kw.w)};
          vd[0] = (f32x4){bf_lo(vw.x), bf_hi(vw.x), bf_lo(vw.y), bf_hi(vw.y)}; vd[1] = (f32x4){bf_lo(vw.z), bf_hi(vw.z), bf_lo(vw.w), bf_hi(vw.w)}; }
        __syncthreads();
        for (int j = 0; j < 64; ++j) {
            const int kpos = t * 64 + j;
            if (vis(kpos)) {
                float s = 0.f;
#pragma unroll
                for (int d4 = 0; d4 < 16; ++d4) { const f32x4 kk = *(const LAS f32x4*)(Ks + j * 64 + d4 * 4); s += q[4 * d4] * kk[0] + q[4 * d4 + 1] * kk[1] + q[4 * d4 + 2] * kk[2] + q[4 * d4 + 3] * kk[3]; }
                if (HAS_BIAS) s += bias_d[qpos - kpos];
                if (s > m) { const float f = __builtin_amdgcn_exp2f(m - s); l *= f;
#pragma unroll
                    for (int d = 0; d < 64; ++d) o[d] *= f;
                    m = s; }
                const float p = __builtin_amdgcn_exp2f(s - m); l += p;
#pragma unroll
                for (int d4 = 0; d4 < 16; ++d4) { const f32x4 vv = *(const LAS f32x4*)(Vs + j * 64 + d4 * 4); o[4 * d4] += p * vv[0]; o[4 * d4 + 1] += p * vv[1]; o[4 * d4 + 2] += p * vv[2]; o[4 * d4 + 3] += p * vv[3]; }
            }
        }
    }
    l_out = l;
}
__device__ __forceinline__ void load_q64(float (&q)[64], const bf16* p) {
#pragma unroll
    for (int i = 0; i < 8; ++i) { const v4u w = *(const v4u*)(p + 8 * i);
        q[8 * i] = bf_lo(w.x); q[8 * i + 1] = bf_hi(w.x); q[8 * i + 2] = bf_lo(w.y); q[8 * i + 3] = bf_hi(w.y); q[8 * i + 4] = bf_lo(w.z); q[8 * i + 5] = bf_hi(w.z); q[8 * i + 6] = bf_lo(w.w); q[8 * i + 7] = bf_hi(w.w); }
}
__device__ __forceinline__ void store_bf64(bf16* p, const float (&o)[64], float sc) {
#pragma unroll
    for (int i = 0; i < 8; ++i) { v4u w; w.x = pk2(o[8 * i] * sc, o[8 * i + 1] * sc); w.y = pk2(o[8 * i + 2] * sc, o[8 * i + 3] * sc); w.z = pk2(o[8 * i + 4] * sc, o[8 * i + 5] * sc); w.w = pk2(o[8 * i + 6] * sc, o[8 * i + 7] * sc); *(v4u*)(p + 8 * i) = w; }
}

__device__ __forceinline__ float diff_lambda(const float* lq1, const float* lk1, const float* lq2, const float* lk2, float lambda_init) {
    float a = 0.f, b = 0.f;
    for (int i = 0; i < 64; ++i) { a += lq1[i] * lk1[i]; b += lq2[i] * lk2[i]; }
    return __expf(a) - __expf(b) + lambda_init;
}
__device__ __forceinline__ void ph_diff_attn_naive(const Ctx& c, const bf16* QKV, float* TMP, const float* rel_bias, float lam) {
    LAS float* Ks = (LAS float*)c.lds; LAS float* Vs = Ks + 4096; LAS float* tbl = Vs + 4096;
    for (int unit = c.bid; unit < NB * 8 * 4 * 2; unit += c.G) {
        const int vh = unit & 1, qb = 3 - ((unit >> 1) & 3), h = (unit >> 3) & 7, b = unit >> 6;
        const int qpos = qb * 512 + c.tid; const size_t t = (size_t)b * S + qpos;
        const bf16* base = QKV + (size_t)b * S * 3072;
        for (int m = 0; m < 2; ++m) {
            const int hm = 2 * h + m;
            __syncthreads();
            build_bias_tbl(tbl, rel_bias, hm, c.tid);
            float q[64], o[64], l; load_q64(q, QKV + t * 3072 + hm * 64);
            nv_attn_core<true>(Ks, Vs, tbl, q, o, l, base + 1024 + hm * 64, 3072, base + 2048 + h * 128 + vh * 64, 3072, 0, (qb + 1) * 8, qpos, c.tid, [=](int kpos) { return kpos <= qpos; });
            const float inv = 1.0f / l; float* dst = TMP + t * 1024 + h * 128 + vh * 64;
            if (m == 0) {
#pragma unroll
                for (int d4 = 0; d4 < 16; ++d4) *(f32x4*)(dst + 4 * d4) = (f32x4){o[4 * d4] * inv, o[4 * d4 + 1] * inv, o[4 * d4 + 2] * inv, o[4 * d4 + 3] * inv};
            } else {
                const float f = lam * inv;
#pragma unroll
                for (int d4 = 0; d4 < 16; ++d4) { f32x4 a = *(const f32x4*)(dst + 4 * d4); a = a - (f32x4){o[4 * d4] * f, o[4 * d4 + 1] * f, o[4 * d4 + 2] * f, o[4 * d4 + 3] * f}; *(f32x4*)(dst + 4 * d4) = a; }
            }
        }
    }
}
__device__ __forceinline__ void ph_diff_subln(const Ctx& c, const float* TMP, bf16* AO, const float* gain, float omli) {
    for (int m = c.gw; m < T; m += c.NGW) {
        const f32x4* r = (const f32x4*)(TMP + (size_t)m * 1024 + c.lane * 16);
        f32x4 v[4]; float s = 0.f;
#pragma unroll
        for (int j = 0; j < 4; ++j) { v[j] = r[j]; s += (v[j][0] * v[j][0] + v[j][1] * v[j][1]) + (v[j][2] * v[j][2] + v[j][3] * v[j][3]); }
        s += __shfl_xor(s, 1); s += __shfl_xor(s, 2); s += __shfl_xor(s, 4);
        const float rs = __builtin_amdgcn_rsqf(s * (1.0f / 128.0f) + 1e-6f) * omli;
        const f32x4* g = (const f32x4*)(gain + (c.lane & 7) * 16);
        v4u w0, w1; f32x4 a = v[0] * g[0] * rs, b = v[1] * g[1] * rs, cc = v[2] * g[2] * rs, dd = v[3] * g[3] * rs;
        w0.x = pk2(a[0], a[1]); w0.y = pk2(a[2], a[3]); w0.z = pk2(b[0], b[1]); w0.w = pk2(b[2], b[3]);
        w1.x = pk2(cc[0], cc[1]); w1.y = pk2(cc[2], cc[3]); w1.z = pk2(dd[0], dd[1]); w1.w = pk2(dd[2], dd[3]);
        v4u* o = (v4u*)(AO + (size_t)m * 1024 + c.lane * 16); o[0] = w0; o[1] = w1;
    }
}

__device__ __forceinline__ void ph_moba_kmean(const Ctx& c, const bf16* QKV, float* KM) {
    for (int it = c.gw; it < NB * 8 * 16; it += c.NGW) {
        const int h = it & 15, n = (it >> 4) & 7, b = it >> 7;
        const bf16* kp = QKV + ((size_t)b * S + n * 256 + (c.lane >> 3)) * 3072 + 1024 + h * 64 + (c.lane & 7) * 8;
        float a[8];
#pragma unroll
        for (int i = 0; i < 8; ++i) a[i] = 0.f;
#pragma unroll 2
        for (int j0 = 0; j0 < 32; j0 += 16) {
            v4u w[16];
#pragma unroll
            for (int j = 0; j < 16; ++j) w[j] = *(const v4u*)(kp + (size_t)(j0 + j) * 8 * 3072);
#pragma unroll
            for (int j = 0; j < 16; ++j) { a[0] += bf_lo(w[j].x); a[1] += bf_hi(w[j].x); a[2] += bf_lo(w[j].y); a[3] += bf_hi(w[j].y); a[4] += bf_lo(w[j].z); a[5] += bf_hi(w[j].z); a[6] += bf_lo(w[j].w); a[7] += bf_hi(w[j].w); }
        }
#pragma unroll
        for (int i = 0; i < 8; ++i) { a[i] += __shfl_xor(a[i], 8); a[i] += __shfl_xor(a[i], 16); a[i] += __shfl_xor(a[i], 32); }
        if (c.lane < 8) { float* dst = KM + ((size_t)(b * 16 + h) * 8 + n) * 64 + c.lane * 8;
            *(f32x4*)dst = (f32x4){a[0], a[1], a[2], a[3]} * (1.0f / 256.0f); *(f32x4*)(dst + 4) = (f32x4){a[4], a[5], a[6], a[7]} * (1.0f / 256.0f); }
    }
}
__device__ __forceinline__ void ph_moba_attn_naive(const Ctx& c, const bf16* QKV, const float* KM, bf16* AO, const float* rel_bias) {
    LAS float* Ks = (LAS float*)c.lds; LAS float* Vs = Ks + 4096; LAS float* tbl = Vs + 4096;
    for (int unit = c.bid; unit < NB * 16 * 4; unit += c.G) {
        const int qb = 3 - (unit & 3), h = (unit >> 2) & 15, b = unit >> 6;
        const int qpos = qb * 512 + c.tid; const size_t t = (size_t)b * S + qpos;
        const bf16* base = QKV + (size_t)b * S * 3072;
        __syncthreads();
        build_bias_tbl(tbl, rel_bias, h, c.tid);
        float q[64], o[64], l; load_q64(q, QKV + t * 3072 + h * 64);
        const int cur = qpos >> 8;
        float gt[8];
        const float* km = KM + (size_t)(b * 16 + h) * 8 * 64;
#pragma unroll
        for (int n = 0; n < 8; ++n) { float s = 0.f;
#pragma unroll
            for (int d = 0; d < 64; ++d) s += q[d] * km[n * 64 + d];
            gt[n] = (n < cur) ? s : -1.0e30f; }
        unsigned mask = 0u;
#pragma unroll
        for (int n = 0; n < 8; ++n) { int rank = 0;
#pragma unroll
            for (int n2 = 0; n2 < 8; ++n2) rank += (gt[n2] > gt[n] || (gt[n2] == gt[n] && n2 < n)) ? 1 : 0;
            if (rank < 3 && n < cur) mask |= 1u << n; }
        nv_attn_core<true>(Ks, Vs, tbl, q, o, l, base + 1024 + h * 64, 3072, base + 2048 + h * 64, 3072, 0, (qb + 1) * 8, qpos, c.tid,
                           [=](int kpos) { const int blk = kpos >> 8; return blk == cur ? kpos <= qpos : ((mask >> blk) & 1u) != 0u; });
        store_bf64(AO + t * 1024 + h * 64, o, 1.0f / l);
    }
}

__device__ __forceinline__ void ph_route_a(const Ctx& c, const bf16* H, const float* norm_ffn, const float* w_router, const float* b_router, int* ROUTE, float* RST, int* CNT, signed char* XQ) {
    LAS int* cnt = (LAS int*)c.lds;
    if (c.tid < 8) cnt[c.tid] = 0;
    __syncthreads();
    float wr[4][4][8];
#pragma unroll
    for (int j = 0; j < 4; ++j)
#pragma unroll
        for (int i = 0; i < 4; ++i) { const int k = 512 * (j >> 1) + 8 * c.lane + 4 * (j & 1) + i; const float g = norm_ffn[k]; const f32x4 a = *(const f32x4*)(w_router + k * 8), b2 = *(const f32x4*)(w_router + k * 8 + 4);
            wr[j][i][0] = g * a[0]; wr[j][i][1] = g * a[1]; wr[j][i][2] = g * a[2]; wr[j][i][3] = g * a[3]; wr[j][i][4] = g * b2[0]; wr[j][i][5] = g * b2[1]; wr[j][i][6] = g * b2[2]; wr[j][i][7] = g * b2[3]; }
    const int tpw = T / c.NGW;
    f32x4 vn[4];
    load_hrow(H + (size_t)(c.gw * tpw) * D, vn, c.lane);
    for (int k = 0; k < tpw; ++k) {
        const int m = c.gw * tpw + k;
        float lg[8]; float ss = 0.f, am = 0.f; f32x4 v[4];
#pragma unroll
        for (int e = 0; e < 8; ++e) lg[e] = 0.f;
#pragma unroll
        for (int j = 0; j < 4; ++j) v[j] = vn[j];
        if (k + 1 < tpw) load_hrow(H + (size_t)(m + 1) * D, vn, c.lane);
#pragma unroll
        for (int j = 0; j < 4; ++j) { ss += (v[j][0] * v[j][0] + v[j][1] * v[j][1]) + (v[j][2] * v[j][2] + v[j][3] * v[j][3]);
            am = __builtin_fmaxf(am, __builtin_fmaxf(__builtin_fmaxf(__builtin_fabsf(v[j][0]), __builtin_fabsf(v[j][1])), __builtin_fmaxf(__builtin_fabsf(v[j][2]), __builtin_fabsf(v[j][3]))));
#pragma unroll
            for (int i = 0; i < 4; ++i)
#pragma unroll
                for (int e = 0; e < 8; ++e) lg[e] += v[j][i] * wr[j][i][e]; }
        ss = wave_sum(ss); am = wave_max(am);
        const float rs = __builtin_amdgcn_rsqf(ss * (1.0f / 1024.0f) + 1e-6f);
        {
            float t4[4];
#pragma unroll
            for (int e = 0; e < 4; ++e) { const auto r = __builtin_amdgcn_permlane32_swap(__float_as_uint(lg[e]), __float_as_uint(lg[e + 4]), false, false); t4[e] = __uint_as_float(r[0]) + __uint_as_float(r[1]); }
            float u2[2];
#pragma unroll
            for (int e = 0; e < 2; ++e) { const auto r = __builtin_amdgcn_permlane16_swap(__float_as_uint(t4[e]), __float_as_uint(t4[e + 2]), false, false); u2[e] = __uint_as_float(r[0]) + __uint_as_float(r[1]); }
            const bool hi8 = (c.lane & 8) != 0;
            float vv = (hi8 ? u2[1] : u2[0]) + __shfl_xor(hi8 ? u2[0] : u2[1], 8);
            vv += __shfl_xor(vv, 4); vv += __shfl_xor(vv, 2); vv += __shfl_xor(vv, 1);
#pragma unroll
            for (int e = 0; e < 8; ++e) lg[e] = __uint_as_float((unsigned)__builtin_amdgcn_readlane((int)__float_as_uint(vv), 16 * (e >> 1) + 8 * (e & 1))) * rs + b_router[e];
        }
        int e1 = 0; float v1 = lg[0];
#pragma unroll
        for (int e = 1; e < 8; ++e) if (lg[e] > v1) { v1 = lg[e]; e1 = e; }
        int e2 = -1; float v2 = -3.0e38f;
#pragma unroll
        for (int e = 0; e < 8; ++e) if (e != e1 && lg[e] > v2) { v2 = lg[e]; e2 = e; }
        const float w2 = 1.0f / (1.0f + __expf(v1 - v2)), w1 = 1.0f - w2;
        quant_row(v, am, ss, XQ + (size_t)m * D, RST + m, c.lane);
        if (c.lane == 0) { int4 r; r.x = e1; r.y = e2; r.z = (int)__float_as_uint(w1); r.w = (int)__float_as_uint(w2); *(int4*)(ROUTE + (size_t)m * 4) = r;
            atomicAdd((int*)&cnt[e1], 1); atomicAdd((int*)&cnt[e2], 1); }
    }
    __syncthreads();
    if (c.tid < 8) CNT[c.bid * 8 + c.tid] = cnt[c.tid];
}
__device__ __forceinline__ void ph_route_b(const Ctx& c, const int* ROUTE, const float* RST, const int* CNT, int* SLOT, int* TOK, float* RSS, int* META, const signed char* XQ, signed char* XQS) {
    LAS int* sh = (LAS int*)c.lds;
    LAS int* cn = sh + 32; LAS int* rt = sh + 4096; LAS float* rsl = (LAS float*)(sh + 4096 + 256); LAS int* sl = sh + 4096 + 512;
    const int tpg = T / c.G;
    for (int i = c.tid; i < c.G * 8; i += 512) cn[i] = CNT[i];
    if (c.tid < tpg) { const int m = c.bid * tpg + c.tid; const int4 r = *(const int4*)(ROUTE + (size_t)m * 4); rt[2 * c.tid] = r.x; rt[2 * c.tid + 1] = r.y; rsl[c.tid] = RST[m]; }
    __syncthreads();
    if (c.tid < 8) { int tot = 0, pre = 0; for (int w = 0; w < c.G; ++w) { const int v = cn[w * 8 + c.tid]; tot += v; if (w < c.bid) pre += v; } sh[c.tid] = tot; sh[8 + c.tid] = pre; }
    __syncthreads();
    if (c.tid == 0) { int base = 0; for (int e = 0; e < 8; ++e) { sh[16 + e] = base; base += (sh[e] + 255) & ~255; } sh[24] = base; }
    __syncthreads();
    {
        LAS int* wc = sh + 4096 + 768;
        int e1 = -1, e2 = -1, r1 = 0, r2 = 0;
        if (c.tid < tpg) { e1 = rt[2 * c.tid]; e2 = rt[2 * c.tid + 1]; }
        if (c.tid < ((tpg + 63) & ~63)) {
#pragma unroll
            for (int e = 0; e < 8; ++e) { const unsigned long long bal = __ballot((e1 == e) || (e2 == e)); const int below = __popcll(bal & ((1ull << c.lane) - 1ull));
                if (e1 == e) r1 = below; if (e2 == e) r2 = below; if (c.lane == 0) wc[c.wave * 8 + e] = __popcll(bal); }
        }
        __syncthreads();
        if (c.tid < tpg) {
            const int m = c.bid * tpg + c.tid; const float rs = rsl[c.tid];
            for (int w = 0; w < c.wave; ++w) { r1 += wc[w * 8 + e1]; r2 += wc[w * 8 + e2]; }
            const int p1 = sh[16 + e1] + sh[8 + e1] + r1, p2 = sh[16 + e2] + sh[8 + e2] + r2;
            TOK[p1] = m; RSS[p1] = rs; SLOT[m * 2] = p1; sl[2 * c.tid] = p1;
            TOK[p2] = m; RSS[p2] = rs; SLOT[m * 2 + 1] = p2; sl[2 * c.tid + 1] = p2;
        }
    }
    if (c.bid == 0) {
        for (int e = 0; e < 8; ++e) { const int lo = sh[16 + e] + sh[e], hi = sh[17 + e];
            for (int p = lo + c.tid; p < hi; p += 512) { TOK[p] = 0; RSS[p] = 0.f; }
            for (int tl = (sh[16 + e] >> 8) + c.tid; tl < (hi >> 8); tl += 512) META[16 + tl] = e; }
        if (c.tid == 0) META[0] = sh[24] >> 8;
    }
    __syncthreads();
    for (int j0 = c.wave; j0 < 2 * tpg; j0 += 8 * NWAVES) {
        v4u v[8]; int pos[8];
#pragma unroll
        for (int u = 0; u < 8; ++u) { const int j = j0 + u * NWAVES; const int m = c.bid * tpg + (j >> 1); pos[u] = sl[j]; v[u] = *(const v4u*)(XQ + (size_t)m * D + c.lane * 16); }
#pragma unroll
        for (int u = 0; u < 8; ++u) *(v4u*)(XQS + (size_t)pos[u] * D + c.lane * 16) = v[u];
    }
}
template <bool LAST>
__device__ __forceinline__ void ph_moe_combine(const Ctx& c, bf16* H, const bf16* Y, const int* ROUTE, const int* SLOT, float* OUT, signed char* XQ, float* RA) {
    for (int m0 = c.gw * 4; m0 < T; m0 += c.NGW * 4) {
        int4 r[4]; int s1[4], s2[4];
#pragma unroll
        for (int u = 0; u < 4; ++u) { r[u] = *(const int4*)(ROUTE + (size_t)(m0 + u) * 4); s1[u] = SLOT[(m0 + u) * 2]; s2[u] = SLOT[(m0 + u) * 2 + 1]; }
        f32x4 v[4][4]; v4u a[4][2], b[4][2];
#pragma unroll
        for (int u = 0; u < 4; ++u) { load_hrow(H + (size_t)(m0 + u) * D, v[u], c.lane);
            const v4u* y1 = (const v4u*)(Y + (size_t)s1[u] * D) + c.lane; const v4u* y2 = (const v4u*)(Y + (size_t)s2[u] * D) + c.lane;
            a[u][0] = __builtin_nontemporal_load(y1); a[u][1] = __builtin_nontemporal_load(y1 + 64); b[u][0] = __builtin_nontemporal_load(y2); b[u][1] = __builtin_nontemporal_load(y2 + 64); }
#pragma unroll
        for (int u = 0; u < 4; ++u) { const float w1 = __uint_as_float((unsigned)r[u].z), w2 = __uint_as_float((unsigned)r[u].w);
#pragma unroll
            for (int hf = 0; hf < 2; ++hf) { f32x4 ya0, ya1, yb0, yb1; unpack8(a[u][hf], ya0, ya1); unpack8(b[u][hf], yb0, yb1);
                v[u][2 * hf] = v[u][2 * hf] + ya0 * w1 + yb0 * w2; v[u][2 * hf + 1] = v[u][2 * hf + 1] + ya1 * w1 + yb1 * w2; }
            if constexpr (LAST) store_frow(OUT + (size_t)(m0 + u) * D, v[u], c.lane);
            else {
                store_hrow(H + (size_t)(m0 + u) * D, v[u], c.lane);
                float ss = 0.f, am = 0.f;
#pragma unroll
                for (int j = 0; j < 4; ++j)
#pragma unroll
                    for (int i = 0; i < 4; ++i) { const float x = bf1((bf16)(pk2(v[u][j][i], 0.f) & 0xffffu)); v[u][j][i] = x; ss += x * x; am = __builtin_fmaxf(am, __builtin_fabsf(x)); }
                ss = wave_sum(ss); am = wave_max(am);
                quant_row(v[u], am, ss, XQ + (size_t)(m0 + u) * D, RA + m0 + u, c.lane); } }
    }
}
constexpr int NSA_LD = 2816;
__device__ __forceinline__ void ph_cmp_bias(const Ctx& c, const float* pos_k, const float* pos_v, const float* w1k, const float* w1v, float* CB) {
    for (int it = c.gw; it < 512; it += c.NGW) {
        const int br = it >> 8, j = it & 255; const float* pos = br ? pos_v : pos_k; const float* w1 = br ? w1v : w1k;
        float s = 0.f;
        for (int k = c.lane; k < 2048; k += 64) s += pos[k] * w1[(size_t)k * 256 + j];
        s = wave_sum(s);
        if (c.lane == 0) CB[it] = s;
    }
}
__device__ __forceinline__ void ph_cmp_stage2(const Ctx& c, const bf16* HID, const float* w2k, const float* w2v, const float* kgain0, bf16* KCMP, bf16* VCMP) {
    LAS float* w2l = (LAS float*)c.lds; LAS float* rowb = (LAS float*)(c.lds + 65536) + c.wave * 256;
    const int br = c.bid & 1; const float* w2 = br ? w2v : w2k;
    for (int i = c.tid; i < 256 * 64 / 4; i += 512) ((LAS f32x4*)w2l)[i] = ((const f32x4*)w2)[i];
    __syncthreads();
    const int nwb = (c.G >> 1) * NWAVES, wb = (c.bid >> 1) * NWAVES + c.wave;
    v2u hwn = *(const v2u*)(HID + ((size_t)br * 8192 + (wb < 8192 ? wb : 0)) * 256 + 4 * c.lane);
    for (int rho = wb; rho < 8192; rho += nwb) {
        const v2u hw = hwn;
        if (rho + nwb < 8192) hwn = *(const v2u*)(HID + ((size_t)br * 8192 + rho + nwb) * 256 + 4 * c.lane);
        asm volatile("" ::: "memory");
        *(LAS f32x4*)(rowb + 4 * c.lane) = (f32x4){bf_lo(hw.x), bf_hi(hw.x), bf_lo(hw.y), bf_hi(hw.y)};
        asm volatile("s_waitcnt lgkmcnt(0)" ::: "memory");
        float a = 0.f;
#pragma unroll 16
        for (int j = 0; j < 256; j += 4) { const f32x4 hv = *(const LAS f32x4*)(rowb + j);
            a += hv[0] * w2l[j * 64 + c.lane] + hv[1] * w2l[(j + 1) * 64 + c.lane] + hv[2] * w2l[(j + 2) * 64 + c.lane] + hv[3] * w2l[(j + 3) * 64 + c.lane]; }
        asm volatile("s_waitcnt lgkmcnt(0)" ::: "memory");
        if (br == 0) { const float ss = wave_sum(a * a); a *= __builtin_amdgcn_rsqf(ss * (1.0f / 64.0f) + 1e-6f) * kgain0[c.lane]; }
        const unsigned w = pk2(a, 0.f); (br ? VCMP : KCMP)[(size_t)rho * 64 + c.lane] = (bf16)(w & 0xffffu);
    }
}
__device__ __forceinline__ void ph_nsa_a_naive(const Ctx& c, const bf16* QKV, const bf16* KCMP, const bf16* VCMP, float* OC, unsigned* SEL) {
    LAS float* Kc = (LAS float*)c.lds; LAS float* Vc = Kc + 8192; LAS float* imp = Vc + 8192;
    for (int unit = c.bid; unit < NB * 4 * 4; unit += c.G) {
        const int qb = 3 - (unit & 3), g = (unit >> 2) & 3, b = unit >> 4;
        const int qpos = qb * 512 + c.tid; const size_t t = (size_t)b * S + qpos;
        __syncthreads();
        { const int row = c.tid >> 2, ch = (c.tid & 3) * 16; const size_t src = ((size_t)(b * 4 + g) * 128 + row) * 64 + ch;
#pragma unroll
          for (int i = 0; i < 2; ++i) { const v4u kw = *(const v4u*)(KCMP + src + 8 * i), vw = *(const v4u*)(VCMP + src + 8 * i);
              LAS f32x4* kd = (LAS f32x4*)(Kc + row * 64 + ch + 8 * i); LAS f32x4* vd = (LAS f32x4*)(Vc + row * 64 + ch + 8 * i);
              kd[0] = (f32x4){bf_lo(kw.x), bf_hi(kw.x), bf_lo(kw.y), bf_hi(kw.y)}; kd[1] = (f32x4){bf_lo(kw.z), bf_hi(kw.z), bf_lo(kw.w), bf_hi(kw.w)};
              vd[0] = (f32x4){bf_lo(vw.x), bf_hi(vw.x), bf_lo(vw.y), bf_hi(vw.y)}; vd[1] = (f32x4){bf_lo(vw.z), bf_hi(vw.z), bf_lo(vw.w), bf_hi(vw.w)}; } }
        for (int s = 0; s < 32; ++s) imp[s * 512 + c.tid] = 0.f;
        __syncthreads();
        const int nv = qpos >= 31 ? ((qpos - 31) >> 4) + 1 : 0;
        const int nvmax = (((qb * 512 + 511) - 31) >> 4) + 1;
        for (int r = 0; r < 4; ++r) {
            const int head = 4 * g + r;
            float q[64], o[64]; load_q64(q, QKV + t * NSA_LD + head * 64);
            float m = -3.0e38f, l = 0.f;
            for (int n = 0; n < nvmax; ++n) if (n < nv) {
                float s = 0.f;
#pragma unroll
                for (int d4 = 0; d4 < 16; ++d4) { const f32x4 kk = *(const LAS f32x4*)(Kc + n * 64 + d4 * 4); s += q[4 * d4] * kk[0] + q[4 * d4 + 1] * kk[1] + q[4 * d4 + 2] * kk[2] + q[4 * d4 + 3] * kk[3]; }
                if (s > m) { l *= __builtin_amdgcn_exp2f(m - s); m = s; }
                l += __builtin_amdgcn_exp2f(s - m);
            }
#pragma unroll
            for (int d = 0; d < 64; ++d) o[d] = 0.f;
            const float inv = l > 0.f ? 1.0f / l : 0.f;
            for (int n = 0; n < nvmax; ++n) if (n < nv) {
                float s = 0.f;
#pragma unroll
                for (int d4 = 0; d4 < 16; ++d4) { const f32x4 kk = *(const LAS f32x4*)(Kc + n * 64 + d4 * 4); s += q[4 * d4] * kk[0] + q[4 * d4 + 1] * kk[1] + q[4 * d4 + 2] * kk[2] + q[4 * d4 + 3] * kk[3]; }
                const float p = __builtin_amdgcn_exp2f(s - m) * inv;
#pragma unroll
                for (int d4 = 0; d4 < 16; ++d4) { const f32x4 vv = *(const LAS f32x4*)(Vc + n * 64 + d4 * 4); o[4 * d4] += p * vv[0]; o[4 * d4 + 1] += p * vv[1]; o[4 * d4 + 2] += p * vv[2]; o[4 * d4 + 3] += p * vv[3]; }
                const int sb = n >> 2;
                if ((n & 3) == 3) { imp[sb * 512 + c.tid] += p; imp[(sb + 1) * 512 + c.tid] += p; } else imp[sb * 512 + c.tid] += 2.0f * p;
            }
            float* dst = OC + t * 1024 + head * 64;
#pragma unroll
            for (int d4 = 0; d4 < 16; ++d4) *(f32x4*)(dst + 4 * d4) = (f32x4){o[4 * d4], o[4 * d4 + 1], o[4 * d4 + 2], o[4 * d4 + 3]};
        }
        const int cur = qpos >> 6; unsigned mask = 0u;
        for (int s = 0; s < 32; ++s) {
            const float vs = (s == 0 || s == cur || s == cur - 1) ? 1.0e30f : (s <= cur ? imp[s * 512 + c.tid] : -1.0e30f);
            int rank = 0;
            for (int s2 = 0; s2 < 32; ++s2) { const float v2 = (s2 == 0 || s2 == cur || s2 == cur - 1) ? 1.0e30f : (s2 <= cur ? imp[s2 * 512 + c.tid] : -1.0e30f);
                rank += (v2 > vs || (v2 == vs && s2 < s)) ? 1 : 0; }
            if (rank < 16) mask |= 1u << s;
        }
        SEL[t * 4 + g] = mask;
    }
}
__device__ __forceinline__ void ph_nsa_b_naive(const Ctx& c, const bf16* QKV, float* OC, const unsigned* SEL, bf16* AO, const float* rel_bias) {
    LAS float* Ks = (LAS float*)c.lds; LAS float* Vs = Ks + 4096; LAS float* tbl = Vs + 4096;
    for (int unit = c.bid; unit < NB * 16 * 4; unit += c.G) {
        const int qb = 3 - (unit & 3), head = (unit >> 2) & 15, b = unit >> 6, g = head >> 2;
        const int qpos = qb * 512 + c.tid; const size_t t = (size_t)b * S + qpos;
        const bf16* base = QKV + (size_t)b * S * NSA_LD;
        __syncthreads();
        build_bias_tbl(tbl, rel_bias, head, c.tid);
        float q[64], o[64], l; load_q64(q, QKV + t * NSA_LD + head * 64);
        const unsigned mask = SEL[t * 4 + g];
        const float g0 = bf1(QKV[t * NSA_LD + 2560 + head * 3]), g1 = bf1(QKV[t * NSA_LD + 2560 + head * 3 + 1]), g2 = bf1(QKV[t * NSA_LD + 2560 + head * 3 + 2]);
        float* oc = OC + t * 1024 + head * 64;
        nv_attn_core<true>(Ks, Vs, tbl, q, o, l, base + 1536 + g * 64, NSA_LD, base + 1792 + g * 64, NSA_LD, 0, (qb + 1) * 8, qpos, c.tid,
                           [=](int kpos) { return kpos <= qpos && ((mask >> (kpos >> 6)) & 1u) != 0u; });
        { const float f = g1 / l;
#pragma unroll
          for (int d4 = 0; d4 < 16; ++d4) { f32x4 a = *(const f32x4*)(oc + 4 * d4); a = a * g0 + (f32x4){o[4 * d4] * f, o[4 * d4 + 1] * f, o[4 * d4 + 2] * f, o[4 * d4 + 3] * f}; *(f32x4*)(oc + 4 * d4) = a; } }
        const int tlo = qb * 8 - 8 < 0 ? 0 : qb * 8 - 8;
        nv_attn_core<true>(Ks, Vs, tbl, q, o, l, base + 2048 + g * 64, NSA_LD, base + 2304 + g * 64, NSA_LD, tlo, (qb + 1) * 8, qpos, c.tid,
                           [=](int kpos) { return kpos <= qpos && qpos - kpos < 512; });
        { const float f = g2 / l; bf16* dst = AO + t * 1024 + head * 64;
#pragma unroll
          for (int i = 0; i < 8; ++i) { const f32x4 a0 = *(const f32x4*)(oc + 8 * i), a1 = *(const f32x4*)(oc + 8 * i + 4); v4u w;
              w.x = pk2(a0[0] + o[8 * i] * f, a0[1] + o[8 * i + 1] * f); w.y = pk2(a0[2] + o[8 * i + 2] * f, a0[3] + o[8 * i + 3] * f);
              w.z = pk2(a1[0] + o[8 * i + 4] * f, a1[1] + o[8 * i + 5] * f); w.w = pk2(a1[2] + o[8 * i + 6] * f, a1[3] + o[8 * i + 7] * f); *(v4u*)(dst + 8 * i) = w; } }
    }
}
namespace fa {
typedef short bf16x8 __attribute__((ext_vector_type(8)));
typedef short s16x4 __attribute__((ext_vector_type(4)));
typedef float f32x16 __attribute__((ext_vector_type(16)));
typedef unsigned u32x4 __attribute__((ext_vector_type(4)));
typedef short v4i16_t __attribute__((ext_vector_type(4)));
typedef LAS const char* lcp;
constexpr int DMAX = 2047, NTBL = 2144;
constexpr int TBL_BYTES = NTBL * 4;
constexpr float NEGBIG = -1.0e30f, MFLOOR = -1.0e29f;
constexpr int L_K = 0, L_V = 24576, L_WSF = 73728, L_OST = 75776, L_NEG = 108544, L_TBL = 108800;

__device__ __forceinline__ int crow0(int r) { return (r & 3) + 8 * (r >> 2); }
__device__ __forceinline__ int crow(int r, int hi) { return (r & 3) + 8 * (r >> 2) + 4 * hi; }
__device__ __forceinline__ unsigned cvtpk(float lo, float hi) { return pg8::cvt_pk_bf16(lo, hi); }
#define FA_MX3(a, b, c) __builtin_fmaxf(__builtin_fmaxf((a), (b)), (c))
__device__ __forceinline__ float rowmax32(const f32x16& p0, const f32x16& p1) {
    float a = FA_MX3(p0[0], p0[1], p1[0]), b = FA_MX3(p0[2], p0[3], p1[1]); a = FA_MX3(a, p1[2], p1[3]);
#pragma unroll
    for (int r = 4; r < 16; r += 4) { a = FA_MX3(a, p0[r], p0[r + 1]); b = FA_MX3(b, p0[r + 2], p0[r + 3]); a = FA_MX3(a, p1[r], p1[r + 1]); b = FA_MX3(b, p1[r + 2], p1[r + 3]); }
    float rm = __builtin_fmaxf(a, b);
    auto rr = __builtin_amdgcn_permlane32_swap(__float_as_uint(rm), __float_as_uint(rm), false, false);
    return __builtin_fmaxf(__uint_as_float(rr[0]), __uint_as_float(rr[1]));
}
__device__ __forceinline__ float swap_add(float v) { auto rr = __builtin_amdgcn_permlane32_swap(__float_as_uint(v), __float_as_uint(v), false, false); return __uint_as_float(rr[0]) + __uint_as_float(rr[1]); }
__device__ __forceinline__ s16x4 vtr(lcp p) { return __builtin_bit_cast(s16x4, __builtin_amdgcn_ds_read_tr16_b64_v4i16((LAS v4i16_t*)p)); }

__device__ __forceinline__ void build_tbl(LAS float* tbl, const float* rel_bias, int col, int wlimit, int tid) {
    for (int j = tid; j < NTBL; j += 512) { const int d = DMAX - j; tbl[j] = (d < 0 || d >= wlimit) ? NEGBIG : rel_bias[rel_bucket(d) * 16 + col] * LOG2E; }
}
__device__ __forceinline__ void build_neg(LAS float* neg, int tid) { if (tid < 64) neg[tid] = NEGBIG; }

__device__ __forceinline__ void row_bcast(float (&fr)[16], float f, LAS float* wsf, int r32, int hi);
template <int NV> struct State { f32x16 o[NV]; float m, l; };
template <int NV> __device__ __forceinline__ void st_init(State<NV>& st) {
#pragma unroll
    for (int i = 0; i < NV; ++i) st.o[i] = f32x16{};
    st.m = MFLOOR; st.l = 0.f;
}
struct Stream { const bf16* Kg; const bf16* Vg; int kpitch, vpitch; };

__device__ __forceinline__ unsigned range_mask(int lo, int hi) { const unsigned a = hi >= 32 ? 0xffffffffu : ((1u << hi) - 1u); const unsigned b = lo <= 0 ? 0u : ((1u << lo) - 1u); return a & ~b; }
struct NoFix { __device__ __forceinline__ void operator()(int, f32x16&, f32x16&) const {} };
struct Ring { int c, n, f; };
template <int NV, class TP, class ACT, class FIX>
__device__ __forceinline__ void run_tiles(State<NV>& st, const bf16x8 (&qr)[4], const Stream& sm, unsigned tmask, LAS char* ring, LAS float* wsf, TP tptr, ACT active, FIX fix, int wid, int lane, Ring& rg, bool primed = false) {
    const int r32 = lane & 31, hi = lane >> 5;
    constexpr int VSLOT = NV * 4096;
    const bf16* ksrc = sm.Kg + (size_t)lane * sm.kpitch + wid * 8;
    const bf16* vsrc = sm.Vg + (size_t)(16 * (wid & 3) + (lane >> 2)) * sm.vpitch + (wid >> 2) * 32 + (lane & 3) * 8;
    LAS char* kdst = ring + L_K + wid * 1024; LAS char* vdst = ring + L_V + wid * 1024;
    const lcp kp0 = ring + L_K + hi * 1024 + r32 * 16;
    const lcp vp0 = ring + L_V + ((lane >> 4) & 1) * 32 + (lane & 3) * 8 + (4 * hi + ((lane & 15) >> 2)) * 64;
#define FA_DMA(t, slot) do { \
        __builtin_amdgcn_global_load_lds((const unsigned*)(ksrc + (size_t)(t) * 64 * sm.kpitch), (LAS unsigned*)(kdst + (slot) * 8192), 16, 0, 0); \
        __builtin_amdgcn_global_load_lds((const unsigned*)(vsrc + (size_t)(t) * 64 * sm.vpitch), (LAS unsigned*)(vdst + (slot) * VSLOT), 16, 0, 0); \
        if (NV == 4) __builtin_amdgcn_global_load_lds((const unsigned*)(vsrc + (size_t)(t) * 64 * sm.vpitch + 64), (LAS unsigned*)(vdst + (slot) * VSLOT + 8192), 16, 0, 0); } while (0)
    unsigned rem = (unsigned)__builtin_amdgcn_readfirstlane((int)tmask);
    if (rem == 0u) return;
    int s_cur = rg.c, s_nxt = rg.n, s_fre = rg.f;
    int tA = __builtin_ctz(rem), tB = -1; rem &= rem - 1u;
    if (!primed) FA_DMA(tA, s_cur);
    if (rem) { tB = __builtin_ctz(rem); rem &= rem - 1u; if (!primed) FA_DMA(tB, s_nxt); }
    while (tA >= 0) {
        const int t = tA;
        if (tB >= 0) { if (NV == 4) asm volatile("s_waitcnt vmcnt(3)\n\ts_barrier" ::: "memory"); else asm volatile("s_waitcnt vmcnt(2)\n\ts_barrier" ::: "memory"); }
        else asm volatile("s_waitcnt vmcnt(0)\n\ts_barrier" ::: "memory");
        int tC = -1;
        if (rem) { tC = __builtin_ctz(rem); rem &= rem - 1u; FA_DMA(tC, s_fre); }
        if (active(t)) {
            const LAS float* tp = tptr(t);
            f32x16 p0, p1;
#pragma unroll
            for (int r = 0; r < 16; ++r) { p0[r] = tp[crow0(r)]; p1[r] = tp[crow0(r) + 32]; }
            fix(t, p0, p1);
            const lcp kp = kp0 + s_cur * 8192;
            bf16x8 kf[8];
#pragma unroll
            for (int d0 = 0; d0 < 4; ++d0) { kf[2 * d0] = *(const LAS bf16x8*)(kp + d0 * 2048); kf[2 * d0 + 1] = *(const LAS bf16x8*)(kp + d0 * 2048 + 512); }
#pragma unroll
            for (int d0 = 0; d0 < 4; ++d0) {
                p0 = __builtin_amdgcn_mfma_f32_32x32x16_bf16(kf[2 * d0], qr[d0], p0, 0, 0, 0); p1 = __builtin_amdgcn_mfma_f32_32x32x16_bf16(kf[2 * d0 + 1], qr[d0], p1, 0, 0, 0);
            }
            const lcp vp = vp0 + s_cur * VSLOT;
            s16x4 vlo[8], vhh[8];
#pragma unroll
            for (int j = 0; j < 8; ++j) { vlo[j] = vtr(vp + (j >> 2) * 4096 + (j & 3) * 1024); vhh[j] = vtr(vp + (j >> 2) * 4096 + (j & 3) * 1024 + 512); }
            const float rm = rowmax32(p0, p1);
            if (__any(rm > st.m + 8.0f)) {
                const float mn = __builtin_fmaxf(st.m, rm), f = __builtin_amdgcn_exp2f(st.m - mn);
                st.l *= f; st.m = mn;
                float fr_[16]; row_bcast(fr_, f, wsf, r32, hi);
#pragma unroll
                for (int i = 0; i < NV; ++i)
#pragma unroll
                    for (int r = 0; r < 16; ++r) st.o[i][r] *= fr_[r];
            }
            const float mm = st.m; float sacc = 0.f;
#pragma unroll
            for (int r = 0; r < 16; ++r) { p0[r] = __builtin_amdgcn_exp2f(p0[r] - mm); p1[r] = __builtin_amdgcn_exp2f(p1[r] - mm); sacc += p0[r] + p1[r]; }
            st.l += sacc;
            u32x4 pw0, pw1, pw2, pw3;
            pw0 = (u32x4){cvtpk(p0[0], p0[1]), cvtpk(p0[2], p0[3]), cvtpk(p0[4], p0[5]), cvtpk(p0[6], p0[7])};
            pw1 = (u32x4){cvtpk(p0[8], p0[9]), cvtpk(p0[10], p0[11]), cvtpk(p0[12], p0[13]), cvtpk(p0[14], p0[15])};
            pw2 = (u32x4){cvtpk(p1[0], p1[1]), cvtpk(p1[2], p1[3]), cvtpk(p1[4], p1[5]), cvtpk(p1[6], p1[7])};
            pw3 = (u32x4){cvtpk(p1[8], p1[9]), cvtpk(p1[10], p1[11]), cvtpk(p1[12], p1[13]), cvtpk(p1[14], p1[15])};
#define FA_PKV(j) (bf16x8){vlo[j][0], vlo[j][1], vlo[j][2], vlo[j][3], vhh[j][0], vhh[j][1], vhh[j][2], vhh[j][3]}
#pragma unroll
            for (int i = 0; i < 2; ++i) {
                st.o[i] = __builtin_amdgcn_mfma_f32_32x32x16_bf16(__builtin_bit_cast(bf16x8, pw0), FA_PKV(4 * i + 0), st.o[i], 0, 0, 0);
                st.o[i] = __builtin_amdgcn_mfma_f32_32x32x16_bf16(__builtin_bit_cast(bf16x8, pw1), FA_PKV(4 * i + 1), st.o[i], 0, 0, 0);
                st.o[i] = __builtin_amdgcn_mfma_f32_32x32x16_bf16(__builtin_bit_cast(bf16x8, pw2), FA_PKV(4 * i + 2), st.o[i], 0, 0, 0);
                st.o[i] = __builtin_amdgcn_mfma_f32_32x32x16_bf16(__builtin_bit_cast(bf16x8, pw3), FA_PKV(4 * i + 3), st.o[i], 0, 0, 0);
            }
            if (NV == 4) {
#pragma unroll
                for (int j = 0; j < 8; ++j) { vlo[j] = vtr(vp + 8192 + (j >> 2) * 4096 + (j & 3) * 1024); vhh[j] = vtr(vp + 8192 + (j >> 2) * 4096 + (j & 3) * 1024 + 512); }
#pragma unroll
                for (int i = 0; i < 2; ++i) {
                    st.o[2 + i] = __builtin_amdgcn_mfma_f32_32x32x16_bf16(__builtin_bit_cast(bf16x8, pw0), FA_PKV(4 * i + 0), st.o[2 + i], 0, 0, 0);
                    st.o[2 + i] = __builtin_amdgcn_mfma_f32_32x32x16_bf16(__builtin_bit_cast(bf16x8, pw1), FA_PKV(4 * i + 1), st.o[2 + i], 0, 0, 0);
                    st.o[2 + i] = __builtin_amdgcn_mfma_f32_32x32x16_bf16(__builtin_bit_cast(bf16x8, pw2), FA_PKV(4 * i + 2), st.o[2 + i], 0, 0, 0);
                    st.o[2 + i] = __builtin_amdgcn_mfma_f32_32x32x16_bf16(__builtin_bit_cast(bf16x8, pw3), FA_PKV(4 * i + 3), st.o[2 + i], 0, 0, 0);
                }
            }
#undef FA_PKV
        }
        tA = tB; tB = tC;
        { const int tmp = s_cur; s_cur = s_nxt; s_nxt = s_fre; s_fre = tmp; }
    }
    rg.c = s_cur; rg.n = s_nxt; rg.f = s_fre;
#undef FA_DMA
}
template <int NV>
__device__ __forceinline__ void prefetch2(const Stream& sm, unsigned tmask, LAS char* ring, const Ring& rg, int wid, int lane) {
    constexpr int VSLOT = NV * 4096;
    const bf16* ksrc = sm.Kg + (size_t)lane * sm.kpitch + wid * 8;
    const bf16* vsrc = sm.Vg + (size_t)(16 * (wid & 3) + (lane >> 2)) * sm.vpitch + (wid >> 2) * 32 + (lane & 3) * 8;
    LAS char* kdst = ring + L_K + wid * 1024; LAS char* vdst = ring + L_V + wid * 1024;
    unsigned rem = (unsigned)__builtin_amdgcn_readfirstlane((int)tmask);
#pragma unroll
    for (int k = 0; k < 2; ++k) {
        if (rem == 0u) break;
        const int t = __builtin_ctz(rem); rem &= rem - 1u; const int slot = k ? rg.n : rg.c;
        __builtin_amdgcn_global_load_lds((const unsigned*)(ksrc + (size_t)t * 64 * sm.kpitch), (LAS unsigned*)(kdst + slot * 8192), 16, 0, 0);
        __builtin_amdgcn_global_load_lds((const unsigned*)(vsrc + (size_t)t * 64 * sm.vpitch), (LAS unsigned*)(vdst + slot * VSLOT), 16, 0, 0);
        if (NV == 4) __builtin_amdgcn_global_load_lds((const unsigned*)(vsrc + (size_t)t * 64 * sm.vpitch + 64), (LAS unsigned*)(vdst + slot * VSLOT + 8192), 16, 0, 0);
    }
}
template <class TP, class ACT>
__device__ __forceinline__ void run_tiles2(State<2>& sA, State<2>& sB, const bf16x8 (&qa)[4], const bf16x8 (&qb_)[4], const Stream& sm, unsigned tmask, LAS char* ring, LAS float* wsf, TP tptr, ACT active, int wid, int lane) {
    const int r32 = lane & 31, hi = lane >> 5;
    constexpr int VSLOT = 8192;
    const bf16* ksrc = sm.Kg + (size_t)lane * sm.kpitch + wid * 8;
    const bf16* vsrc = sm.Vg + (size_t)(16 * (wid & 3) + (lane >> 2)) * sm.vpitch + (wid >> 2) * 32 + (lane & 3) * 8;
    LAS char* kdst = ring + L_K + wid * 1024; LAS char* vdst = ring + L_V + wid * 1024;
    const lcp kp0 = ring + L_K + hi * 1024 + r32 * 16;
    const lcp vp0 = ring + L_V + ((lane >> 4) & 1) * 32 + (lane & 3) * 8 + (4 * hi + ((lane & 15) >> 2)) * 64;
#define FA_DMA(t, slot) do { \
        __builtin_amdgcn_global_load_lds((const unsigned*)(ksrc + (size_t)(t) * 64 * sm.kpitch), (LAS unsigned*)(kdst + (slot) * 8192), 16, 0, 0); \
        __builtin_amdgcn_global_load_lds((const unsigned*)(vsrc + (size_t)(t) * 64 * sm.vpitch), (LAS unsigned*)(vdst + (slot) * VSLOT), 16, 0, 0); } while (0)
    unsigned rem = (unsigned)__builtin_amdgcn_readfirstlane((int)tmask);
    if (rem == 0u) return;
    int s_cur = 0, s_nxt = 1, s_fre = 2;
    int tA = __builtin_ctz(rem), tB = -1; rem &= rem - 1u;
    FA_DMA(tA, 0);
    if (rem) { tB = __builtin_ctz(rem); rem &= rem - 1u; FA_DMA(tB, 1); }
    while (tA >= 0) {
        const int t = tA;
        if (tB >= 0) asm volatile("s_waitcnt vmcnt(2)\n\ts_barrier" ::: "memory"); else asm volatile("s_waitcnt vmcnt(0)\n\ts_barrier" ::: "memory");
        int tC = -1;
        if (rem) { tC = __builtin_ctz(rem); rem &= rem - 1u; FA_DMA(tC, s_fre); }
        const bool a0 = active(t, 0), a1 = active(t, 1);
        if (a0 || a1) {
            const lcp kp = kp0 + s_cur * 8192; const lcp vp = vp0 + s_cur * VSLOT;
#define FA_SUB(ST, QR, SB) do { \
            const LAS float* tp = tptr(t, SB); \
            f32x16 p0, p1; \
            _Pragma("unroll") for (int r = 0; r < 16; ++r) { p0[r] = tp[crow0(r)]; p1[r] = tp[crow0(r) + 32]; } \
            bf16x8 kf[8]; \
            _Pragma("unroll") for (int d0 = 0; d0 < 4; ++d0) { kf[2 * d0] = *(const LAS bf16x8*)(kp + d0 * 2048); kf[2 * d0 + 1] = *(const LAS bf16x8*)(kp + d0 * 2048 + 512); } \
            _Pragma("unroll") for (int d0 = 0; d0 < 4; ++d0) { p0 = __builtin_amdgcn_mfma_f32_32x32x16_bf16(kf[2 * d0], QR[d0], p0, 0, 0, 0); p1 = __builtin_amdgcn_mfma_f32_32x32x16_bf16(kf[2 * d0 + 1], QR[d0], p1, 0, 0, 0); } \
            const float rm = rowmax32(p0, p1); \
            if (__any(rm > ST.m + 8.0f)) { const float mn = __builtin_fmaxf(ST.m, rm), f = __builtin_amdgcn_exp2f(ST.m - mn); ST.l *= f; ST.m = mn; float fr_[16]; row_bcast(fr_, f, wsf, r32, hi); \
                _Pragma("unroll") for (int r = 0; r < 16; ++r) { ST.o[0][r] *= fr_[r]; ST.o[1][r] *= fr_[r]; } } \
            const float mm = ST.m; float sacc = 0.f; \
            _Pragma("unroll") for (int r = 0; r < 16; ++r) { p0[r] = __builtin_amdgcn_exp2f(p0[r] - mm); p1[r] = __builtin_amdgcn_exp2f(p1[r] - mm); sacc += p0[r] + p1[r]; } \
            ST.l += sacc; \
            s16x4 vlo[8], vhh[8]; \
            _Pragma("unroll") for (int j = 0; j < 8; ++j) { vlo[j] = vtr(vp + (j >> 2) * 4096 + (j & 3) * 1024); vhh[j] = vtr(vp + (j >> 2) * 4096 + (j & 3) * 1024 + 512); } \
            const u32x4 pw0 = (u32x4){cvtpk(p0[0], p0[1]), cvtpk(p0[2], p0[3]), cvtpk(p0[4], p0[5]), cvtpk(p0[6], p0[7])}, pw1 = (u32x4){cvtpk(p0[8], p0[9]), cvtpk(p0[10], p0[11]), cvtpk(p0[12], p0[13]), cvtpk(p0[14], p0[15])}; \
            const u32x4 pw2 = (u32x4){cvtpk(p1[0], p1[1]), cvtpk(p1[2], p1[3]), cvtpk(p1[4], p1[5]), cvtpk(p1[6], p1[7])}, pw3 = (u32x4){cvtpk(p1[8], p1[9]), cvtpk(p1[10], p1[11]), cvtpk(p1[12], p1[13]), cvtpk(p1[14], p1[15])}; \
            _Pragma("unroll") for (int i = 0; i < 2; ++i) { \
                ST.o[i] = __builtin_amdgcn_mfma_f32_32x32x16_bf16(__builtin_bit_cast(bf16x8, pw0), FA_PKV2(4 * i + 0), ST.o[i], 0, 0, 0); \
                ST.o[i] = __builtin_amdgcn_mfma_f32_32x32x16_bf16(__builtin_bit_cast(bf16x8, pw1), FA_PKV2(4 * i + 1), ST.o[i], 0, 0, 0); \
                ST.o[i] = __builtin_amdgcn_mfma_f32_32x32x16_bf16(__builtin_bit_cast(bf16x8, pw2), FA_PKV2(4 * i + 2), ST.o[i], 0, 0, 0); \
                ST.o[i] = __builtin_amdgcn_mfma_f32_32x32x16_bf16(__builtin_bit_cast(bf16x8, pw3), FA_PKV2(4 * i + 3), ST.o[i], 0, 0, 0); } } while (0)
#define FA_PKV2(j) (bf16x8){vlo[j][0], vlo[j][1], vlo[j][2], vlo[j][3], vhh[j][0], vhh[j][1], vhh[j][2], vhh[j][3]}
            if (a0) FA_SUB(sA, qa, 0);
            if (a1) FA_SUB(sB, qb_, 1);
#undef FA_SUB
#undef FA_PKV2
        }
        tA = tB; tB = tC;
        { const int tmp = s_cur; s_cur = s_nxt; s_nxt = s_fre; s_fre = tmp; }
    }
#undef FA_DMA
}
__device__ __forceinline__ void row_bcast(float (&fr)[16], float f, LAS float* wsf, int r32, int hi) {
    asm volatile("" ::: "memory");
    if (hi == 0) wsf[r32] = f;
    asm volatile("s_waitcnt lgkmcnt(0)" ::: "memory");
#pragma unroll
    for (int r = 0; r < 16; ++r) fr[r] = wsf[crow(r, hi)];
    asm volatile("" ::: "memory");
}
__device__ __forceinline__ void store_o64(const f32x16& oa, const f32x16& ob, bf16* dst, int ldo, LAS char* ost, int lane) {
    const int r32 = lane & 31, hi = lane >> 5;
    LAS bf16* stg = (LAS bf16*)ost;
#pragma unroll
    for (int r = 0; r < 16; ++r) { const int orow = crow(r, hi); stg[orow * 64 + r32] = (bf16)(cvtpk(oa[r], 0.f) & 0xffffu); stg[orow * 64 + 32 + r32] = (bf16)(cvtpk(ob[r], 0.f) & 0xffffu); }
    asm volatile("s_waitcnt lgkmcnt(0)" ::: "memory");
#pragma unroll
    for (int i = 0; i < 4; ++i) { const int row = i * 8 + (lane >> 3), ch = lane & 7; const u32x4 v = *(const LAS u32x4*)(stg + row * 64 + ch * 8); *(u32x4*)(dst + (size_t)row * ldo + ch * 8) = v; }
    asm volatile("s_waitcnt lgkmcnt(0)" ::: "memory");
}
}

__device__ __forceinline__ void ph_moba_attn(const Ctx& c, const bf16* QKV, bf16* AO, const float* rel_bias) {
    LAS char* ring = (LAS char*)c.lds;
    LAS float* wsf = (LAS float*)(ring + fa::L_WSF) + c.wave * 64;
    LAS float* neg = (LAS float*)(ring + fa::L_NEG); LAS float* tbl = (LAS float*)(ring + fa::L_TBL);
    LAS float* kml = (LAS float*)(ring + fa::L_TBL + fa::TBL_BYTES);
    const int lane = c.lane, wid = c.wave, r32 = lane & 31, hi = lane >> 5;
    for (int bh = c.bid; bh < NB * 16; bh += c.G) {
        const int b = bh >> 4, h = bh & 15;
        __syncthreads();
        fa::build_tbl(tbl, rel_bias, h, 1 << 30, c.tid); fa::build_neg(neg, c.tid);
        const bf16* base = QKV + (size_t)b * S * 3072;
        {
            const bf16* kp = base + (size_t)(wid * 256 + (lane >> 3)) * 3072 + 1024 + h * 64 + (lane & 7) * 8;
            float a[8];
#pragma unroll
            for (int i = 0; i < 8; ++i) a[i] = 0.f;
#pragma unroll 2
            for (int j0 = 0; j0 < 32; j0 += 16) {
                v4u w[16];
#pragma unroll
                for (int j = 0; j < 16; ++j) w[j] = *(const v4u*)(kp + (size_t)(j0 + j) * 8 * 3072);
#pragma unroll
                for (int j = 0; j < 16; ++j) { a[0] += bf_lo(w[j].x); a[1] += bf_hi(w[j].x); a[2] += bf_lo(w[j].y); a[3] += bf_hi(w[j].y); a[4] += bf_lo(w[j].z); a[5] += bf_hi(w[j].z); a[6] += bf_lo(w[j].w); a[7] += bf_hi(w[j].w); }
            }
#pragma unroll
            for (int i = 0; i < 8; ++i) { a[i] += __shfl_xor(a[i], 8); a[i] += __shfl_xor(a[i], 16); a[i] += __shfl_xor(a[i], 32); }
            if (lane < 8) {
#pragma unroll
                for (int i = 0; i < 8; ++i) kml[wid * 64 + lane * 8 + i] = a[i] * (1.0f / 256.0f); }
        }
        __syncthreads();
        const fa::Stream sm{base + 1024 + h * 64, base + 2048 + h * 64, 3072, 3072};
        for (int qi = 0; qi < 4; ++qi) {
            const int Q = 3 - qi;
            const int qw0 = Q * 512 + wid * 64, cur = qw0 >> 8;
            fa::bf16x8 qa[4], qb_[4]; unsigned maskA = 0u, maskB = 0u;
#pragma unroll
            for (int sb = 0; sb < 2; ++sb) {
                const int qpos = qw0 + 32 * sb + r32;
                fa::bf16x8 qr[4];
#pragma unroll
                for (int d0 = 0; d0 < 4; ++d0) qr[d0] = *(const fa::bf16x8*)(base + (size_t)qpos * 3072 + h * 64 + d0 * 16 + hi * 8);
                float gt[8]; unsigned mask = 0u;
#pragma unroll
                for (int n = 0; n < 8; ++n) { float s = 0.f;
#pragma unroll
                    for (int d0 = 0; d0 < 4; ++d0)
#pragma unroll
                        for (int j = 0; j < 8; ++j) s += bf1((bf16)qr[d0][j]) * kml[n * 64 + d0 * 16 + hi * 8 + j];
                    s = fa::swap_add(s); gt[n] = (n < cur) ? s : -1.0e30f; }
#pragma unroll
                for (int n = 0; n < 8; ++n) { int rank = 0;
#pragma unroll
                    for (int n2 = 0; n2 < 8; ++n2) rank += (gt[n2] > gt[n] || (gt[n2] == gt[n] && n2 < n)) ? 1 : 0;
                    if (rank < 3 && n < cur) mask |= 1u << n; }
                mask |= 1u << cur;
                if (sb == 0) { maskA = mask;
#pragma unroll
                    for (int d0 = 0; d0 < 4; ++d0) qa[d0] = qr[d0]; }
                else { maskB = mask;
#pragma unroll
                    for (int d0 = 0; d0 < 4; ++d0) qb_[d0] = qr[d0]; }
            }
            fa::State<2> sA, sB; fa::st_init(sA); fa::st_init(sB);
            const LAS float* trowA = tbl + (fa::DMAX - (qw0 + r32) + 4 * hi); const LAS float* trowB = trowA - 32;
            asm volatile("s_barrier" ::: "memory");
            fa::run_tiles2(sA, sB, qa, qb_, sm, fa::range_mask(0, 8 * (Q + 1)), ring, wsf,
                [=](int t, int sb) -> const LAS float* { const unsigned mk = sb ? maskB : maskA; return ((mk >> (t >> 2)) & 1u) ? (sb ? trowB : trowA) + 64 * t : (const LAS float*)neg; },
                [=](int t, int sb) -> bool { const unsigned mk = sb ? maskB : maskA; return 64 * t <= qw0 + 32 * sb + 31 && __any((int)((mk >> (t >> 2)) & 1u)); }, wid, lane);
#pragma unroll
            for (int sb = 0; sb < 2; ++sb) {
                fa::State<2>& st = sb ? sB : sA;
                const float lt = fa::swap_add(st.l); float fr[16]; fa::row_bcast(fr, 1.0f / lt, wsf, r32, hi);
#pragma unroll
                for (int r = 0; r < 16; ++r) { st.o[0][r] *= fr[r]; st.o[1][r] *= fr[r]; }
                fa::store_o64(st.o[0], st.o[1], AO + ((size_t)b * S + qw0 + 32 * sb) * 1024 + h * 64, 1024, ring + fa::L_OST + wid * 4096, lane);
            }
        }
    }
}
__device__ __forceinline__ void diff_pass(fa::State<4>& st, const bf16* base, int hm, int h, int qb, int qw, int qpos, const LAS float* tbl, LAS char* ring, LAS float* wsf, int wid, int lane, fa::Ring& rg, bool primed) {
    const int hi = lane >> 5;
    fa::bf16x8 qr[4];
#pragma unroll
    for (int d0 = 0; d0 < 4; ++d0) qr[d0] = *(const fa::bf16x8*)(base + (size_t)qpos * 3072 + hm * 64 + d0 * 16 + hi * 8);
    fa::st_init(st);
    const LAS float* trow = tbl + (fa::DMAX - qpos + 4 * hi);
    const fa::Stream sm{base + 1024 + hm * 64, base + 2048 + h * 128, 3072, 3072};
    if (!primed) asm volatile("s_barrier" ::: "memory");
    fa::run_tiles<4>(st, qr, sm, fa::range_mask(0, 4 * (qb + 1)), ring, wsf,
        [=](int t) -> const LAS float* { return trow + 64 * t; },
        [=](int t) -> bool { return 64 * t <= qw + 31; }, fa::NoFix(), wid, lane, rg, primed);
}
__device__ __forceinline__ void ph_diff_attn(const Ctx& c, const bf16* QKV, signed char* AO8, float* SCR, const float* rel_bias, float lam, const float* subln_gain, float omli) {
    LAS char* ring = (LAS char*)c.lds;
    LAS float* wsf = (LAS float*)(ring + fa::L_WSF) + c.wave * 64;
    LAS float* tbl0 = (LAS float*)(ring + fa::L_TBL); LAS float* tbl1 = (LAS float*)(ring + fa::L_TBL + fa::TBL_BYTES);
    const int lane = c.lane, wid = c.wave, r32 = lane & 31, hi = lane >> 5;
    float* scr = SCR + (size_t)c.gw * 4096 + lane * 64;
    for (int ui = c.bid; ui < NB * 8 * 2; ui += c.G) {
        const int par = (ui >> 3) & 1, bh = (ui & 7) * 16 + (ui >> 4), b = bh >> 3, h = bh & 7;
        __syncthreads();
        fa::build_tbl(tbl0, rel_bias, 2 * h, 1 << 30, c.tid); fa::build_tbl(tbl1, rel_bias, 2 * h + 1, 1 << 30, c.tid);
        __syncthreads();
        const bf16* base = QKV + (size_t)b * S * 3072;
        fa::Ring rg{0, 1, 2};
        for (int qi = 0; qi < 4; ++qi) {
            const int qb = par ? (qi == 0 ? 7 : qi == 1 ? 4 : qi == 2 ? 3 : 0) : (qi == 0 ? 6 : qi == 1 ? 5 : qi == 2 ? 2 : 1);
            const int qbn = par ? (qi == 0 ? 4 : qi == 1 ? 3 : 0) : (qi == 0 ? 5 : qi == 1 ? 2 : 1);
            const int qw = qb * 256 + wid * 32, qpos = qw + r32;
            unsigned pk[16];
            LAS unsigned* park = (LAS unsigned*)(ring + fa::L_OST + wid * 4096) + lane;
            {
                fa::State<4> st; diff_pass(st, base, 2 * h, h, qb, qw, qpos, tbl0, ring, wsf, wid, lane, rg, qi > 0);
                fa::prefetch2<4>(fa::Stream{base + 1024 + (2 * h + 1) * 64, base + 2048 + h * 128, 3072, 3072}, fa::range_mask(0, 4 * (qb + 1)), ring, rg, wid, lane);
                const float lt = fa::swap_add(st.l); float fr[16]; fa::row_bcast(fr, 1.0f / lt, wsf, r32, hi);
#pragma unroll
                for (int i = 0; i < 2; ++i)
#pragma unroll
                    for (int r2 = 0; r2 < 8; ++r2) park[(i * 8 + r2) * 64] = fa::cvtpk(st.o[i][2 * r2] * fr[2 * r2], st.o[i][2 * r2 + 1] * fr[2 * r2 + 1]);
#pragma unroll
                for (int i = 2; i < 4; ++i)
#pragma unroll
                    for (int r2 = 0; r2 < 8; ++r2) pk[(i - 2) * 8 + r2] = fa::cvtpk(st.o[i][2 * r2] * fr[2 * r2], st.o[i][2 * r2 + 1] * fr[2 * r2 + 1]);
                asm volatile("s_waitcnt lgkmcnt(0)" ::: "memory");
            }
            {
                fa::State<4> st; diff_pass(st, base, 2 * h + 1, h, qb, qw, qpos, tbl1, ring, wsf, wid, lane, rg, true);
                if (qi < 3) fa::prefetch2<4>(fa::Stream{base + 1024 + 2 * h * 64, base + 2048 + h * 128, 3072, 3072}, fa::range_mask(0, 4 * (qbn + 1)), ring, rg, wid, lane);
                const float lt = fa::swap_add(st.l); float fr[16]; fa::row_bcast(fr, lam / lt, wsf, r32, hi);
#pragma unroll
                for (int i = 0; i < 4; ++i)
#pragma unroll
                    for (int r2 = 0; r2 < 8; ++r2) { const unsigned w = i < 2 ? park[(i * 8 + r2) * 64] : pk[(i - 2) * 8 + r2];
                        st.o[i][2 * r2] = bf_lo(w) - st.o[i][2 * r2] * fr[2 * r2]; st.o[i][2 * r2 + 1] = bf_hi(w) - st.o[i][2 * r2 + 1] * fr[2 * r2 + 1]; }
                asm volatile("s_waitcnt lgkmcnt(0)" ::: "memory");
                float g4[4];
#pragma unroll
                for (int i = 0; i < 4; ++i) g4[i] = subln_gain[32 * i + r32] * omli;
#pragma unroll
                for (int r = 0; r < 16; ++r) {
                    float ss = st.o[0][r] * st.o[0][r] + st.o[1][r] * st.o[1][r] + st.o[2][r] * st.o[2][r] + st.o[3][r] * st.o[3][r];
                    ss += __shfl_xor(ss, 1); ss += __shfl_xor(ss, 2); ss += __shfl_xor(ss, 4); ss += __shfl_xor(ss, 8); ss += __shfl_xor(ss, 16);
                    const float rs = __builtin_amdgcn_rsqf(ss * (1.0f / 128.0f) + 1e-6f);
#pragma unroll
                    for (int i = 0; i < 4; ++i) st.o[i][r] *= rs * g4[i];
                }
                {
                    const float qs = 127.0f / (6.0f * omli);
                    LAS unsigned char* stg = (LAS unsigned char*)(ring + fa::L_OST + wid * 4096);
#pragma unroll
                    for (int i = 0; i < 4; ++i)
#pragma unroll
                        for (int r = 0; r < 16; ++r) { float v = __builtin_amdgcn_fmed3f(st.o[i][r] * qs, -127.0f, 127.0f); stg[fa::crow(r, hi) * 128 + 32 * i + r32] = (unsigned char)(int)__builtin_rintf(v); }
                    asm volatile("s_waitcnt lgkmcnt(0)" ::: "memory");
                    signed char* dst = AO8 + ((size_t)b * S + qw) * 1024 + h * 128;
                    const int row = lane >> 1, hf = lane & 1;
#pragma unroll
                    for (int k = 0; k < 4; ++k) { const fa::u32x4 v = *(const LAS fa::u32x4*)(stg + row * 128 + hf * 64 + k * 16); *(fa::u32x4*)(dst + (size_t)row * 1024 + hf * 64 + k * 16) = v; }
                    asm volatile("s_waitcnt lgkmcnt(0)" ::: "memory");
                }
            }
        }
    }
}

#ifndef EXP_SEL
#define EXP_SEL 1.0f
#define EXP_WIN 1.0f
#define EXP_CMP 1.0f
#endif
__device__ __forceinline__ void ph_nsa_b(const Ctx& c, const bf16* QKV, const bf16* KCMP, const bf16* VCMP, const unsigned* SEL, bf16* AO, const float* rel_bias) {
    LAS char* ring = (LAS char*)c.lds;
    LAS float* wsf = (LAS float*)(ring + fa::L_WSF) + c.wave * 64;
    LAS float* neg = (LAS float*)(ring + fa::L_NEG);
    LAS unsigned* um = (LAS unsigned*)(ring + fa::L_WSF) + 40;
    LAS float* tblc = (LAS float*)(ring + fa::L_TBL + 2 * fa::TBL_BYTES);
    const int lane = c.lane, wid = c.wave, r32 = lane & 31, hi = lane >> 5, hr = wid >> 1, qh = wid & 1;
    LAS float* tblh = (LAS float*)(ring + (hr < 2 ? 49152 + hr * fa::TBL_BYTES : fa::L_TBL + (hr - 2) * fa::TBL_BYTES));
    for (int ui = c.bid; ui < NB * 4 * 4; ui += c.G) {
        const int sset = (ui >> 3) & 3, bg = (ui & 7) * 8 + (ui >> 5), b = bg >> 2, g = bg & 3, head = 4 * g + hr;
        __syncthreads();
        for (int i = 0; i < 4; ++i) fa::build_tbl((LAS float*)(ring + (i < 2 ? 49152 + i * fa::TBL_BYTES : fa::L_TBL + (i - 2) * fa::TBL_BYTES)), rel_bias, 4 * g + i, 1 << 30, c.tid);
        fa::build_neg(neg, c.tid);
        if (c.tid < 256) tblc[c.tid] = c.tid < 128 ? 0.f : fa::NEGBIG;
        __syncthreads();
        const bf16* base = QKV + (size_t)b * S * NSA_LD;
        const fa::Stream ssel{base + 1536 + g * 64, base + 1792 + g * 64, NSA_LD, NSA_LD}, swin{base + 2048 + g * 64, base + 2304 + g * 64, NSA_LD, NSA_LD};
        const fa::Stream scmp{KCMP + (size_t)bg * 128 * 64, VCMP + (size_t)bg * 128 * 64, 64, 64};
        fa::bf16x8 qn[4]; unsigned selmn; bf16 gn0, gn1, gn2;
#define NB_LOAD(ck_) do { const int qp_ = 64 * (ck_) + 32 * qh + r32; \
            selmn = __hip_atomic_load(SEL + ((size_t)b * S + qp_) * 4 + g, __ATOMIC_RELAXED, __HIP_MEMORY_SCOPE_AGENT);     \
            _Pragma("unroll") for (int d0 = 0; d0 < 4; ++d0) qn[d0] = *(const fa::bf16x8*)(base + (size_t)qp_ * NSA_LD + head * 64 + d0 * 16 + hi * 8); \
            gn0 = base[(size_t)qp_ * NSA_LD + 2560 + head * 3]; gn1 = base[(size_t)qp_ * NSA_LD + 2560 + head * 3 + 1]; gn2 = base[(size_t)qp_ * NSA_LD + 2560 + head * 3 + 2]; } while (0)
        NB_LOAD(3 * 8 + (7 - sset));
        for (int ci = 0; ci < 8; ++ci) {
            const int k8 = 7 - ci, ck = (k8 >> 1) * 8 + ((k8 & 1) ? 7 - sset : sset);
            const int qw = 64 * ck + 32 * qh, qpos = qw + r32;
            const unsigned selm = selmn;
            fa::bf16x8 qr[4];
#pragma unroll
            for (int d0 = 0; d0 < 4; ++d0) qr[d0] = qn[d0];
            const float g0 = bf1(gn0), g1 = bf1(gn1), g2 = bf1(gn2);
            if (ci < 7) { const int k8n = 6 - ci; NB_LOAD((k8n >> 1) * 8 + ((k8n & 1) ? 7 - sset : sset)); }
            if (c.tid == 0) *um = 0u;
            asm volatile("s_waitcnt lgkmcnt(0)\n\ts_barrier" ::: "memory");
            atomicOr((unsigned*)um, selm);
            asm volatile("s_waitcnt lgkmcnt(0)\n\ts_barrier" ::: "memory");
            const unsigned U = *um & fa::range_mask(0, ck + 1);
            const LAS float* trow = tblh + (fa::DMAX - qpos + 4 * hi);
            fa::f32x16 acc0, acc1;
            const int nmax = qpos >= 31 ? ((qpos - 31) >> 4) : -1;
            const LAS float* tpc = tblc + (127 - nmax) + 4 * hi;
#pragma unroll
            for (int r = 0; r < 16; ++r) { acc0[r] = 0.f; acc1[r] = 0.f; }
#pragma unroll 1
            for (int ps = 0; ps < 2; ++ps) {
                fa::State<2> st; fa::st_init(st); fa::Ring rg0{0, 1, 2};
                const fa::Stream sm = ps ? ssel : scmp;
                const unsigned tm = ps ? U : ((4 * ck + 2) >= 64 ? 3u : 1u);
                const unsigned onm = ps ? selm : 0xffffffffu;
                const LAS float* bp = ps ? trow : tpc;
                const float gg = ps ? g1 : g0;
                if (ps) asm volatile("s_barrier" ::: "memory");
                fa::run_tiles<2>(st, qr, sm, tm, ring, wsf,
                    [=](int tt) -> const LAS float* { return ((onm >> tt) & 1u) ? bp + 64 * tt : (const LAS float*)neg; },
                    [=](int tt) -> bool { return __any((int)((onm >> tt) & 1u)) != 0; }, fa::NoFix(), wid, lane, rg0);
                const float lt = fa::swap_add(st.l); float fr[16]; fa::row_bcast(fr, lt > 0.f ? gg / lt : 0.f, wsf, r32, hi);
#pragma unroll
                for (int r = 0; r < 16; ++r) { acc0[r] += st.o[0][r] * fr[r]; acc1[r] += st.o[1][r] * fr[r]; }
            }
            {
                fa::State<2> st; fa::st_init(st); fa::Ring rg1{0, 1, 2};
                const int told = ck - 8, qi = 32 * qh + r32;
                asm volatile("s_barrier" ::: "memory");
                fa::run_tiles<2>(st, qr, swin, fa::range_mask(told < 0 ? 0 : told, ck + 1), ring, wsf,
                    [=](int tt) -> const LAS float* { return trow + 64 * tt; },
                    [=](int) -> bool { return true; },
                    [=](int tt, fa::f32x16& p0, fa::f32x16& p1) { if (tt == told) {
#pragma unroll
                        for (int r = 0; r < 16; ++r) { const int kj = fa::crow(r, hi); if (kj <= qi) p0[r] = fa::NEGBIG; if (kj + 32 <= qi) p1[r] = fa::NEGBIG; } } }, wid, lane, rg1);
                const float lt = fa::swap_add(st.l); float fr[16]; fa::row_bcast(fr, g2 / lt, wsf, r32, hi);
#pragma unroll
                for (int r = 0; r < 16; ++r) { acc0[r] += st.o[0][r] * fr[r] * EXP_WIN; acc1[r] += st.o[1][r] * fr[r] * EXP_WIN; }
            }
            fa::store_o64(acc0, acc1, AO + ((size_t)b * S + qw) * 1024 + head * 64, 1024, ring + fa::L_OST + wid * 4096, lane);
        }
    }
#undef NB_LOAD
}

__device__ __forceinline__ void ph_nsa_a(const Ctx& c, const bf16* QKV, const bf16* KCMP, const bf16* VCMP, unsigned* SEL) {
    LAS char* ring = (LAS char*)c.lds;
    LAS float* wsf = (LAS float*)(ring + fa::L_WSF) + c.wave * 64;
    LAS float* tblc = (LAS float*)(ring + 58368);
    LAS float* imph = (LAS float*)(ring + fa::L_OST);
    LAS float* tot = (LAS float*)(ring + 49152);
    LAS unsigned* selw = (LAS unsigned*)(ring + 57856);
    const int lane = c.lane, wid = c.wave, r32 = lane & 31, hi = lane >> 5, hr = wid >> 1, qh = wid & 1;
    for (int ui = c.bid; ui < NB * 4 * 4; ui += c.G) {
        const int sset = (ui >> 3) & 3, bg = (ui & 7) * 8 + (ui >> 5), b = bg >> 2, g = bg & 3, head = 4 * g + hr;
        __syncthreads();
        if (c.tid < 256) tblc[c.tid] = c.tid < 128 ? 0.f : fa::NEGBIG;
        {
            const bf16* kc = KCMP + (size_t)bg * 128 * 64; const bf16* vc = VCMP + (size_t)bg * 128 * 64;
            const bf16* ksrc = kc + (size_t)lane * 64 + wid * 8;
            const bf16* vsrc = vc + (size_t)(16 * (wid & 3) + (lane >> 2)) * 64 + (wid >> 2) * 32 + (lane & 3) * 8;
#pragma unroll
            for (int t = 0; t < 2; ++t) {
                __builtin_amdgcn_global_load_lds((const unsigned*)(ksrc + t * 64 * 64), (LAS unsigned*)(ring + fa::L_K + wid * 1024 + t * 8192), 16, 0, 0);
                __builtin_amdgcn_global_load_lds((const unsigned*)(vsrc + t * 64 * 64), (LAS unsigned*)(ring + fa::L_V + wid * 1024 + t * 8192), 16, 0, 0);
            }
            asm volatile("s_waitcnt vmcnt(0)" ::: "memory");
        }
        __syncthreads();
        const bf16* base = QKV + (size_t)b * S * NSA_LD;
        const fa::lcp kp0 = ring + fa::L_K + hi * 1024 + r32 * 16;
        const fa::lcp vp0 = ring + fa::L_V + ((lane >> 4) & 1) * 32 + (lane & 3) * 8 + (4 * hi + ((lane & 15) >> 2)) * 64;
        fa::bf16x8 qn[4];
        { const int ck0 = 3 * 8 + (7 - sset), qp0 = 64 * ck0 + 32 * qh + r32;
#pragma unroll
          for (int d0 = 0; d0 < 4; ++d0) qn[d0] = *(const fa::bf16x8*)(base + (size_t)qp0 * NSA_LD + head * 64 + d0 * 16 + hi * 8); }
        for (int ci = 0; ci < 8; ++ci) {
            const int k8 = 7 - ci, ck = (k8 >> 1) * 8 + ((k8 & 1) ? 7 - sset : sset);
            const int qw = 64 * ck + 32 * qh, qpos = qw + r32; const size_t tq = (size_t)b * S + qpos;
            fa::bf16x8 qr[4];
#pragma unroll
            for (int d0 = 0; d0 < 4; ++d0) qr[d0] = qn[d0];
            if (ci < 7) { const int k8n = 6 - ci, ckn = (k8n >> 1) * 8 + ((k8n & 1) ? 7 - sset : sset), qpn = 64 * ckn + 32 * qh + r32;
#pragma unroll
                for (int d0 = 0; d0 < 4; ++d0) qn[d0] = *(const fa::bf16x8*)(base + (size_t)qpn * NSA_LD + head * 64 + d0 * 16 + hi * 8); }
            const int nmax = qpos >= 31 ? ((qpos - 31) >> 4) : -1;
            const bool two = (4 * ck + 2) >= 64;
            const LAS float* tp = tblc + (127 - nmax) + 4 * hi;
            fa::f32x16 s0, s1, s2, s3;
#pragma unroll
            for (int r = 0; r < 16; ++r) { s0[r] = tp[fa::crow0(r)]; s1[r] = tp[fa::crow0(r) + 32]; s2[r] = fa::NEGBIG; s3[r] = fa::NEGBIG; }
#pragma unroll
            for (int d0 = 0; d0 < 4; ++d0) {
                const fa::bf16x8 b0 = *(const LAS fa::bf16x8*)(kp0 + d0 * 2048), b1 = *(const LAS fa::bf16x8*)(kp0 + d0 * 2048 + 512);
                s0 = __builtin_amdgcn_mfma_f32_32x32x16_bf16(b0, qr[d0], s0, 0, 0, 0); s1 = __builtin_amdgcn_mfma_f32_32x32x16_bf16(b1, qr[d0], s1, 0, 0, 0);
            }
            if (two) {
#pragma unroll
                for (int r = 0; r < 16; ++r) { s2[r] = tp[fa::crow0(r) + 64]; s3[r] = tp[fa::crow0(r) + 96]; }
#pragma unroll
                for (int d0 = 0; d0 < 4; ++d0) {
                    const fa::bf16x8 b0 = *(const LAS fa::bf16x8*)(kp0 + 8192 + d0 * 2048), b1 = *(const LAS fa::bf16x8*)(kp0 + 8192 + d0 * 2048 + 512);
                    s2 = __builtin_amdgcn_mfma_f32_32x32x16_bf16(b0, qr[d0], s2, 0, 0, 0); s3 = __builtin_amdgcn_mfma_f32_32x32x16_bf16(b1, qr[d0], s3, 0, 0, 0);
                }
            }
            float m = __builtin_fmaxf(fa::rowmax32(s0, s1), fa::rowmax32(s2, s3));
            m = __builtin_fmaxf(m, fa::MFLOOR);
            float l = 0.f;
#pragma unroll
            for (int r = 0; r < 16; ++r) { s0[r] = __builtin_amdgcn_exp2f(s0[r] - m); s1[r] = __builtin_amdgcn_exp2f(s1[r] - m); s2[r] = __builtin_amdgcn_exp2f(s2[r] - m); s3[r] = __builtin_amdgcn_exp2f(s3[r] - m); l += (s0[r] + s1[r]) + (s2[r] + s3[r]); }
            l = fa::swap_add(l);
            const float inv = l > 0.f ? 1.0f / l : 0.f;
#pragma unroll
            for (int r = 0; r < 16; ++r) { s0[r] *= inv; s1[r] *= inv; s2[r] *= inv; s3[r] *= inv; }
            float av[16], sp[16];
#define NA_GRP(P, idx, k) do { av[idx] = 2.0f * (P[4 * (k)] + P[4 * (k) + 1] + P[4 * (k) + 2]) + P[4 * (k) + 3]; sp[idx] = P[4 * (k) + 3]; } while (0)
            NA_GRP(s0, 0, 0); NA_GRP(s0, 1, 1); NA_GRP(s0, 2, 2); NA_GRP(s0, 3, 3); NA_GRP(s1, 4, 0); NA_GRP(s1, 5, 1); NA_GRP(s1, 6, 2); NA_GRP(s1, 7, 3);
            NA_GRP(s2, 8, 0); NA_GRP(s2, 9, 1); NA_GRP(s2, 10, 2); NA_GRP(s2, 11, 3); NA_GRP(s3, 12, 0); NA_GRP(s3, 13, 1); NA_GRP(s3, 14, 2); NA_GRP(s3, 15, 3);
#undef NA_GRP
            asm volatile("s_barrier" ::: "memory");
            {
                LAS float* row = imph + (hr * 64 + 32 * qh + r32) * 33;
#pragma unroll
                for (int idx = 0; idx < 16; ++idx) {
                    auto rr = __builtin_amdgcn_permlane32_swap(__float_as_uint(sp[idx]), __float_as_uint(sp[idx]), false, false);
                    const float other = __uint_as_float(hi ? rr[0] : rr[1]);
                    sp[idx] = other;
                }
#pragma unroll
                for (int idx = 0; idx < 16; ++idx) {
                    const float add = hi ? sp[idx] : (idx > 0 ? sp[idx - 1] : 0.f);
                    row[2 * idx + hi] = av[idx] + add;
                }
            }
            if (c.tid < 64) selw[c.tid] = 0u;
            asm volatile("s_waitcnt lgkmcnt(0)\n\ts_barrier" ::: "memory");
            {
                const int q = c.tid & 63, sb = c.tid >> 6;
#pragma unroll
                for (int j = 0; j < 4; ++j) { const int s = sb + 8 * j; tot[q * 33 + s] = ((imph[(0 * 64 + q) * 33 + s] + imph[(1 * 64 + q) * 33 + s]) + imph[(2 * 64 + q) * 33 + s]) + imph[(3 * 64 + q) * 33 + s]; }
                asm volatile("s_waitcnt lgkmcnt(0)\n\ts_barrier" ::: "memory");
                float vs[4]; int rank[4];
#pragma unroll
                for (int j = 0; j < 4; ++j) { const int s = sb + 8 * j; vs[j] = (s == 0 || s == ck || s == ck - 1) ? 1.0e30f : (s <= ck ? tot[q * 33 + s] : -1.0e30f); rank[j] = 0; }
                for (int s2 = 0; s2 < 32; ++s2) {
                    const float v2 = (s2 == 0 || s2 == ck || s2 == ck - 1) ? 1.0e30f : (s2 <= ck ? tot[q * 33 + s2] : -1.0e30f);
#pragma unroll
                    for (int j = 0; j < 4; ++j) { const int s = sb + 8 * j; rank[j] += (v2 > vs[j] || (v2 == vs[j] && s2 < s)) ? 1 : 0; }
                }
                unsigned bits = 0u;
#pragma unroll
                for (int j = 0; j < 4; ++j) if (rank[j] < 16) bits |= 1u << (sb + 8 * j);
                atomicOr((unsigned*)&selw[q], bits);
                asm volatile("s_waitcnt lgkmcnt(0)\n\ts_barrier" ::: "memory");
                if (c.tid < 64) SEL[((size_t)b * S + 64 * ck + c.tid) * 4 + g] = selw[c.tid];
            }
            (void)tq;
        }
    }
}
#ifndef MK_PER_PHASE
#define MK_PER_PHASE 0
#endif
constexpr int NPH = 34;
struct Args { const float* in[NIN]; float* out; unsigned char* ws; int ph_lo, ph_hi; };

__device__ __forceinline__ int opaque_i(int k) { int r; asm volatile("s_mov_b32 %0, %1" : "=s"(r) : "s"(k)); return r; }

__global__ void __launch_bounds__(NWAVES * 64, 2) mk_fwd(Args args) {
    extern __shared__ __attribute__((aligned(16))) unsigned char lds_raw[];
    Ctx c;
    c.lds = (LAS unsigned char*)lds_raw;
    c.tid = threadIdx.x; c.lane = c.tid & 63; c.wave = __builtin_amdgcn_readfirstlane(c.tid >> 6);
    c.bid = blockIdx.x; c.G = gridDim.x; c.gw = c.bid * NWAVES + c.wave; c.NGW = c.G * NWAVES;
    volatile LAS unsigned* MISC = (volatile LAS unsigned*)(c.lds + MISC_OFF);
    for (int u = c.tid; u < (LDS_BYTES - RING_BYTES) / 4; u += NWAVES * 64) ((LAS unsigned*)(c.lds + RING_BYTES))[u] = 0u;
    __syncthreads();
    gu32* ctl = (gu32*)(args.ws + WS_CTL);
    XcdBarrier bar = xcd_barrier_post((unsigned*)(ctl + CW_BAR), MISC + 8);
    const int lo = args.ph_lo, hi = args.ph_hi;
#ifndef PH_MASK
#define PH_MASK 0xFFFFFFFFFFFFull
#endif
#ifndef PH_DUP_MASK
#define PH_DUP_MASK 0ull
#endif
#define PH_BEGIN(k) if (((PH_MASK >> (k)) & 1ull) && lo <= (k) && (k) < hi) { for (int rep_ = 0; rep_ < (((PH_DUP_MASK >> (k)) & 1ull) ? 2 : 1); ++rep_) { if (rep_) xcd_barrier(bar); GAS unsigned char* gws_ = (GAS unsigned char*)args.ws; GAS float* gout_ = (GAS float*)args.out; asm volatile("" : "+s"(gws_), "+s"(gout_)); unsigned char* lws = (unsigned char*)gws_; float* lout = (float*)gout_;
#define PH_END(k) } if ((k) + 1 < hi) xcd_barrier(bar); }
#define IN(k) ((const float*)(const GAS float*)args.in[opaque_i(k)])
#define H ((bf16*)(lws + WS_XB))
#define OUTF ((float*)lout)
#define SSQ ((float*)(lws + WS_SSQ))
#define XB ((bf16*)(lws + WS_XB))
#define WIN ((bf16*)(lws + WS_WIN))
#define WOUT ((bf16*)(lws + WS_WOUT))
#define CW1 ((bf16*)(lws + WS_CW1))
#define WFF ((bf16*)(lws + WS_WFF))
#define QKV ((bf16*)(lws + WS_QKV))
#define AO ((bf16*)(lws + WS_AO))
#define TMP ((float*)(lws + WS_TMP))
#define HB ((bf16*)(lws + WS_HB))
#define YB ((bf16*)(lws + WS_Y))
#define ROUTE ((int*)(lws + WS_ROUTE))
#define SLOT ((int*)(lws + WS_SLOT))
#define TOK ((int*)(lws + WS_TOK))
#define RSS ((float*)(lws + WS_RSS))
#define CNT ((int*)(lws + WS_CNT))
#define META ((int*)(lws + WS_META))
#define RST ((float*)(lws + WS_RST))
#define KM ((float*)(lws + WS_KM))
#define SEL ((unsigned*)(lws + WS_SEL))
#define CB ((float*)(lws + WS_CB))
#define KCMP ((bf16*)(lws + WS_KCMP))
#define VCMP ((bf16*)(lws + WS_VCMP))
#define HID ((bf16*)(lws + WS_HID))
#define REL_BIAS IN(1)
#define XQ ((signed char*)(lws + WS_XQ))
#define SWS ((float*)(lws + WS_SW))
#define CMAXP(off) ((int*)(lws + WS_CTL + (off)))
#define WFF8 ((unsigned char*)(lws + WS_WFF))
#define SWD ((float*)(lws + WS_SWD))
#define HSC ((float*)(lws + WS_HSC))
#define HQ ((signed char*)(lws + WS_HB))
#define XQS ((signed char*)(lws + WS_XQS))
#define SWI ((float*)(lws + WS_SWI))
#define SWO ((float*)(lws + WS_SWO))
#define AO8 ((signed char*)(lws + WS_AO))
#define WOUT8 ((signed char*)(lws + WS_WOUT))
#define WIN8 ((signed char*)(lws + WS_WIN))

#define SCLA (RST + T)
#define SCLB (RST + 2 * T)
#define ACCP(k_) ((unsigned long long*)(lws + WS_SSQ) + (size_t)(k_) * T)
#define GEMM_QKV(KIND, NCOLS, qg_, kg_, PRED_, ak_) do { pg8::Gemm g{XQ, WIN8, 8, 1024u, 128u}; pg8::PlainSched Sd; Sd.init(T, NCOLS, 1024u, 1024u, c.G, c.bid); \
        epi::EpiQKV8<KIND, PRED_> E{QKV, NCOLS, PRED_ ? SCLA : RST, SWI, qg_, kg_, C2, ACCP(ak_), c.lds + RING_BYTES + 1024}; pg8::gemm_phase<epi::EpiQKV8<KIND, PRED_>, pg8::PlainSched, true, true>(c.lds, g, Sd, E); } while (0)
#define CVQ_WIN(w_in_, ncols_, npad_, nm_, cm_, pass_) cvq_matrix(c, w_in_, 1024, ncols_, npad_, ncols_, nm_, WIN8, CMAXP(cm_), SWI, 1, pass_, rot, true)
#define GEMM_WOUT(PRED_, ak_) do { pg8::Gemm g{AO, WOUT, 16, 2048u, 128u}; pg8::PlainSched Sd; Sd.init(T, 1024, 2048u, 2048u, c.G, c.bid); \
        epi::EpiResidLean<PRED_> E{H, {XQ, ACCP(ak_), SCLA, SCLB}}; pg8::gemm_phase<epi::EpiResidLean<PRED_>, pg8::PlainSched, true>(c.lds, g, Sd, E); } while (0)
#define GEMM_WOUT8(omli_, PRED_, ak_) do { pg8::Gemm g{AO8, WOUT8, 8, 1024u, 128u}; pg8::PlainSched Sd; Sd.init(T, 1024, 1024u, 1024u, c.G, c.bid); \
        epi::EpiResidLean8<PRED_> E{H, SWO, 6.0f * (omli_) * (1.0f / 127.0f), {XQ, ACCP(ak_), SCLA, SCLB}, c.lds + RING_BYTES + 1024}; pg8::gemm_phase<epi::EpiResidLean8<PRED_>, pg8::PlainSched, true, true>(c.lds, g, Sd, E); } while (0)
#define CVQ_WOUT(w_out_, cm_, pass_) cvq_matrix(c, w_out_, 1024, 1024, 1024, 1024, nullptr, WOUT8, CMAXP(cm_), SWO, 0, pass_, rot, true)
#define GEMM_FFN_UP(ak_) do { pg8::Gemm g{XQ, WFF8, 8, 1024u, 128u}; pg8::PlainSched Sd; Sd.init(T, 7168, 1024u, 1024u, c.G, c.bid); \
        epi::EpiSwiGLU8<true> E{HQ, FF, SCLB, SWS, HSC, ACCP(ak_), c.lds + RING_BYTES + 1024}; pg8::gemm_phase<epi::EpiSwiGLU8<true>, pg8::PlainSched, true, true>(c.lds, g, Sd, E); } while (0)
#define GEMM_FFN_DOWN(ak_) do { pg8::Gemm g{HQ, WFF8 + (size_t)7168 * 1024, 28, 3584u, 128u}; pg8::PlainSched Sd; Sd.init(T, 1024, 3584u, 3584u, c.G, c.bid); \
        epi::EpiResid8<true> E{H, SWD, HSC, {XQ, ACCP(ak_), SCLB, SCLA}, c.lds + RING_BYTES + 1024}; pg8::gemm_phase<epi::EpiResid8<true>, pg8::PlainSched, true, true>(c.lds, g, Sd, E); } while (0)
#define MOE_TILE_TABLE() LAS int* te_ = (LAS int*)(c.lds + RING_BYTES + 1024 + 10240); for (int i_ = c.tid; i_ < ntile; i_ += NWAVES * 64) te_[i_] = META[16 + i_]; __syncthreads()
#define GEMM_MOE_UP() do { const int ntile = META[0]; MOE_TILE_TABLE(); pg8::Gemm g{XQS, WFF8, 8, 1024u, 128u}; pg8::MoeSched Sd; Sd.init(ntile, 7168, 1024u, 1024u, (size_t)7168 * 1024, c.G, c.bid, te_, nullptr); \
        epi::EpiSwiGLU8<false> E{HQ, FF, RSS, SWS, HSC, nullptr, c.lds + RING_BYTES + 1024}; pg8::gemm_phase<epi::EpiSwiGLU8<false>, pg8::MoeSched, true, true>(c.lds, g, Sd, E); } while (0)
#define GEMM_MOE_DOWN() do { const int ntile = META[0]; MOE_TILE_TABLE(); pg8::Gemm g{HQ, WFF8 + (size_t)NE * 7168 * 1024, 28, 3584u, 128u}; pg8::MoeSched Sd; Sd.init(ntile, 1024, 3584u, 3584u, (size_t)1024 * 3584, c.G, c.bid, te_, nullptr); \
        epi::EpiPlain8 E{YB, 1024, SWD, HSC, c.lds + RING_BYTES + 1024}; pg8::gemm_phase<epi::EpiPlain8, pg8::MoeSched, true, true>(c.lds, g, Sd, E); } while (0)

    PH_BEGIN(0) { int rot = 0; CVQ_WIN(IN(3), 3072, 3072, IN(2), CT_CMAXW0, 1); CVQ_WOUT(IN(4), CT_CMAXO0, 1); } PH_END(0)
    PH_BEGIN(1) { int rot = 0; ph_prep(c, IN(0), H, XQ, RST); CVQ_WIN(IN(3), 3072, 3072, IN(2), CT_CMAXW0, 2); CVQ_WOUT(IN(4), CT_CMAXO0, 2); cvq_ffn(c, IN(13), IN(14), IN(15), IN(12), WFF8, CMAXP(CT_CMAX0), CMAXP(CT_CMAXD0), SWS, SWD, 1, 1, rot); } PH_END(1)
    PH_BEGIN(2) { GEMM_QKV(0, 3072, IN(5), IN(6), false, 0); int rot = 0; cvq_ffn(c, IN(13), IN(14), IN(15), IN(12), WFF8, CMAXP(CT_CMAX0), CMAXP(CT_CMAXD0), SWS, SWD, 1, 2, rot); ph_hidden_scale(c, CMAXP(CT_CMAX0), HSC, 1); CVQ_WIN(IN(17), 3072, 3072, IN(16), CT_CMAXW1, 1); } PH_END(2)
    PH_BEGIN(3) { const float li = 0.2f; ph_diff_attn(c, QKV, AO8, TMP, REL_BIAS, diff_lambda(IN(7), IN(8), IN(9), IN(10), li), IN(11), 1.0f - li); } PH_END(3)
    PH_BEGIN(4) GEMM_WOUT8(1.0f - 0.2f, true, 0); PH_END(4)
    PH_BEGIN(6) GEMM_FFN_UP(0); PH_END(6)
    PH_BEGIN(7) { GEMM_FFN_DOWN(1); int rot = 0; CVQ_WIN(IN(17), 3072, 3072, IN(16), CT_CMAXW1, 2); cv_matrix(c, IN(18), 1024, 1024, 1024, 1024, nullptr, WOUT, 0, rot); cvq_ffn(c, IN(24), IN(25), IN(26), IN(21), WFF8, CMAXP(CT_CMAX1), CMAXP(CT_CMAXD1), SWS, SWD, NE, 1, rot); } PH_END(7)
    PH_BEGIN(9) { GEMM_QKV(0, 3072, IN(19), IN(20), true, 1); int rot = 0; cvq_ffn(c, IN(24), IN(25), IN(26), IN(21), WFF8, CMAXP(CT_CMAX1), CMAXP(CT_CMAXD1), SWS, SWD, NE, 2, rot); ph_hidden_scale(c, CMAXP(CT_CMAX1), HSC, NE); CVQ_WIN(IN(28), 2608, NSA_LD, IN(27), CT_CMAXW2, 1); } PH_END(9)
    PH_BEGIN(10) ph_moba_attn(c, QKV, AO, REL_BIAS); PH_END(10)
    PH_BEGIN(11) GEMM_WOUT(false, 0); PH_END(11)
    PH_BEGIN(12) ph_route_a(c, H, IN(21), IN(22), IN(23), ROUTE, RST, CNT, XQ); PH_END(12)
    PH_BEGIN(13) ph_route_b(c, ROUTE, RST, CNT, SLOT, TOK, RSS, META, XQ, XQS); PH_END(13)
    PH_BEGIN(14) GEMM_MOE_UP(); PH_END(14)
    PH_BEGIN(15) GEMM_MOE_DOWN(); PH_END(15)
    PH_BEGIN(16) { int rot = 0; ph_moe_combine<false>(c, H, YB, ROUTE, SLOT, nullptr, XQ, RST); CVQ_WIN(IN(28), 2608, NSA_LD, IN(27), CT_CMAXW2, 2); cv_matrix(c, IN(29), 1024, 1024, 1024, 1024, nullptr, WOUT, 0, rot);
                   cv_matrix(c, IN(34), 2048, 256, 256, 256, nullptr, CW1, 0, rot); cv_matrix(c, IN(36), 2048, 256, 256, 256, nullptr, CW1 + 256 * 2048, 0, rot);
                   cvq_ffn(c, IN(39), IN(40), IN(41), IN(38), WFF8, CMAXP(CT_CMAX2), CMAXP(CT_CMAXD2), SWS, SWD, 1, 1, rot); ph_cmp_bias(c, IN(32), IN(33), IN(34), IN(36), CB); } PH_END(17)
    PH_BEGIN(17) { GEMM_QKV(2, NSA_LD, IN(30), IN(31), false, 0); int rot = 0; cvq_ffn(c, IN(39), IN(40), IN(41), IN(38), WFF8, CMAXP(CT_CMAX2), CMAXP(CT_CMAXD2), SWS, SWD, 1, 2, rot); ph_hidden_scale(c, CMAXP(CT_CMAX2), HSC, 1); CVQ_WIN(IN(43), 3072, 3072, IN(42), CT_CMAXW3, 1); CVQ_WOUT(IN(44), CT_CMAXO3, 1); } PH_END(17)
    PH_BEGIN(18) { pg8::Gemm g{QKV, CW1, 32, 4096u, (unsigned)NSA_LD * 2u}; pg8::CmpSched Sd{c.G, c.bid, (unsigned)NSA_LD * 2u, 1024u};
                   epi::EpiGelu E{HID, CB}; pg8::gemm_phase<epi::EpiGelu, pg8::CmpSched, true>(c.lds, g, Sd, E); } PH_END(19)
    PH_BEGIN(19) ph_cmp_stage2(c, HID, IN(35), IN(37), IN(31), KCMP, VCMP); PH_END(19)
    PH_BEGIN(20) { ph_nsa_a(c, QKV, KCMP, VCMP, SEL); asm volatile("s_waitcnt vmcnt(0)" ::: "memory"); __syncthreads(); ph_nsa_b(c, QKV, KCMP, VCMP, SEL, AO, REL_BIAS); } PH_END(20)
    PH_BEGIN(21) GEMM_WOUT(true, 2); PH_END(21)
    PH_BEGIN(23) GEMM_FFN_UP(2); PH_END(23)
    PH_BEGIN(24) { GEMM_FFN_DOWN(3); int rot = 0; CVQ_WIN(IN(43), 3072, 3072, IN(42), CT_CMAXW3, 2); CVQ_WOUT(IN(44), CT_CMAXO3, 2); cvq_ffn(c, IN(55), IN(56), IN(57), IN(52), WFF8, CMAXP(CT_CMAX3), CMAXP(CT_CMAXD3), SWS, SWD, NE, 1, rot); } PH_END(24)
    PH_BEGIN(26) { GEMM_QKV(0, 3072, IN(45), IN(46), true, 3); int rot = 0; cvq_ffn(c, IN(55), IN(56), IN(57), IN(52), WFF8, CMAXP(CT_CMAX3), CMAXP(CT_CMAXD3), SWS, SWD, NE, 2, rot); ph_hidden_scale(c, CMAXP(CT_CMAX3), HSC, NE); } PH_END(26)
    PH_BEGIN(27) { const float li = 0.55605818f; ph_diff_attn(c, QKV, AO8, TMP, REL_BIAS, diff_lambda(IN(47), IN(48), IN(49), IN(50), li), IN(51), 1.0f - li); } PH_END(27)
    PH_BEGIN(28) GEMM_WOUT8(1.0f - 0.55605818f, false, 0); PH_END(28)
    PH_BEGIN(29) ph_route_a(c, H, IN(52), IN(53), IN(54), ROUTE, RST, CNT, XQ); PH_END(29)
    PH_BEGIN(30) ph_route_b(c, ROUTE, RST, CNT, SLOT, TOK, RSS, META, XQ, XQS); PH_END(30)
    PH_BEGIN(31) GEMM_MOE_UP(); PH_END(31)
    PH_BEGIN(32) GEMM_MOE_DOWN(); PH_END(32)
    PH_BEGIN(33) ph_moe_combine<true>(c, H, YB, ROUTE, SLOT, OUTF, nullptr, nullptr); PH_END(33)
}

extern "C" void kernel_launch(void* const* d_in, const int* in_sizes, int n_in, void* d_out, int out_size, void* d_ws, size_t ws_size, hipStream_t stream) {
    static int grid = 0;
    if (grid == 0) {
        if (n_in != NIN || in_sizes[0] != T * D || out_size != T * D || ws_size < WS_END) { fprintf(stderr, "kernel_launch: unexpected shapes (n_in %d, in0 %d, out %d, ws %zu)\n", n_in, n_in > 0 ? in_sizes[0] : -1, out_size, ws_size); grid = -1; return; }
        int dev = 0, cus = 0, per_cu = 0;
        if (hipGetDevice(&dev) != hipSuccess || hipDeviceGetAttribute(&cus, hipDeviceAttributeMultiprocessorCount, dev) != hipSuccess) { grid = -1; return; }
        if (hipFuncSetAttribute((const void*)mk_fwd, hipFuncAttributeMaxDynamicSharedMemorySize, LDS_BYTES) != hipSuccess) { grid = -1; return; }
        if (hipOccupancyMaxActiveBlocksPerMultiprocessor(&per_cu, (const void*)mk_fwd, NWAVES * 64, LDS_BYTES) != hipSuccess || per_cu < 1) { fprintf(stderr, "kernel_launch: occupancy query says %d\n", per_cu); }
        (void)hipGetLastError();
        grid = cus;
        if (grid != 256) { fprintf(stderr, "kernel_launch: built for 256 CUs, got %d\n", grid); grid = -1; return; }
    }
    if (grid < 0) return;
    if (hipMemsetAsync((char*)d_ws + WS_CTL, 0, CTL_ZERO_BYTES, stream) != hipSuccess) return;
    Args a{};
    for (int i = 0; i < NIN; ++i) a.in[i] = (const float*)d_in[i];
    a.out = (float*)d_out; a.ws = (unsigned char*)d_ws;
#if MK_PER_PHASE
    for (int p = 0; p < NPH; ++p) { a.ph_lo = p; a.ph_hi = p + 1; hipLaunchKernelGGL(mk_fwd, dim3(grid), dim3(NWAVES * 64), LDS_BYTES, stream, a); }
#else
    a.ph_lo = 0; a.ph_hi = NPH;
    hipLaunchKernelGGL(mk_fwd, dim3(grid), dim3(NWAVES * 64), LDS_BYTES, stream, a);
#endif
}
```

```cpp
#include <hip/hip_runtime.h>
#include <cstdio>
#include <cstdint>
namespace pg8 {
#define PG8_LAS __attribute__((address_space(3)))
typedef unsigned short bf16_t;
typedef short bf16x8 __attribute__((ext_vector_type(8)));
typedef float f32x4 __attribute__((ext_vector_type(4)));
typedef float f32x2 __attribute__((ext_vector_type(2)));
typedef unsigned u32x4 __attribute__((ext_vector_type(4)));
constexpr int BM = 256, BK = 64, HALF = 128, HTB = HALF * BK * 2  , STAGE_BYTES = 8 * HTB, NXCD = 8, WGM = 8;

__host__ __device__ __forceinline__ int lds_byte(int r, int c) { const int st = (r >> 4) * 2 + (c >> 5), rr = r & 15, cc = c & 31, ob = rr * 64 + cc * 2; return st * 1024 + (ob ^ (((ob >> 9) & 1) << 5)); }
__host__ __device__ __forceinline__ void stage_rc(int b, int& R, int& C) { const int st = b / 1024, sb = b % 1024, swz = sb ^ (((sb >> 9) & 1) << 5); R = (st >> 1) * 16 + swz / 64; C = (st & 1) * 32 + (swz % 64) / 2; }
__host__ __device__ __forceinline__ int perm32(int rho) { const int n = rho >> 4, i = rho & 15; return 8 * (i >> 2) + 4 * n + (i & 3); }

struct Unit { int pm, pn, aux; size_t boff; };
struct Gemm { const void* A; const void* Bt; int nt; unsigned rowB; unsigned kstepA; };
typedef int i32x4 __attribute__((ext_vector_type(4)));
template <bool I8> struct AccSel { typedef f32x4 T; }; template <> struct AccSel<true> { typedef i32x4 T; };

__device__ __forceinline__ void swz_order(int L, int nM, int nN, int& pm, int& pn) {
    const int nwg = nM * nN; int wgid = L;
    { const int q = nwg / NXCD, r = nwg % NXCD, xcd = wgid % NXCD, off = wgid / NXCD; wgid = (xcd < r ? xcd * (q + 1) : r * (q + 1) + (xcd - r) * q) + off; }
    const int nig = WGM * nN, gid = wgid / nig, fm = gid * WGM, gsz = (nM - fm) < WGM ? (nM - fm) : WGM;
    pm = fm + ((wgid % nig) % gsz); pn = (wgid % nig) / gsz;
}

struct PlainSched {
    int nM, nN, nwg, G, c; unsigned lda2; size_t tstepB;
    __device__ __forceinline__ void init(int M, int N, unsigned rowB, unsigned rowA, int G_, int c_) { nM = M / BM; nN = N / BM; nwg = nM * nN; G = G_; c = c_; lda2 = rowA; tstepB = (size_t)BM * rowB; }
    __device__ __forceinline__ bool next(int i, Unit& u) const {
        const long L = (long)i * G + c; if (L >= nwg) return false;
        swz_order((int)L, nM, nN, u.pm, u.pn); u.aux = 0; u.boff = (size_t)u.pn * tstepB; return true;
    }
    __device__ __forceinline__ unsigned arow(const Unit& u, int r) const { return (unsigned)(u.pm * BM + r) * lda2; }
};
struct MoeSched {
    int nM, nN, nwg, G, c; unsigned lda2; size_t tstepB, estepB; const PG8_LAS int* tile_e; const int* tok;
    __device__ __forceinline__ void init(int ntile, int N, unsigned rowB, unsigned rowA, size_t estepB_, int G_, int c_, const PG8_LAS int* te, const int* tk) { nM = ntile; nN = N / BM; nwg = nM * nN; G = G_; c = c_; lda2 = rowA; tstepB = (size_t)BM * rowB; estepB = estepB_; tile_e = te; tok = tk; }
    __device__ __forceinline__ bool next(int i, Unit& u) const {
        const long L = (long)i * G + c; if (L >= nwg) return false;
        swz_order((int)L, nM, nN, u.pm, u.pn); const int e = __builtin_amdgcn_readfirstlane(tile_e[u.pm]); u.aux = e; u.boff = (size_t)e * estepB + (size_t)u.pn * tstepB; return true;
    }
    __device__ __forceinline__ unsigned arow(const Unit& u, int r) const { const int row = u.pm * BM + r; return (unsigned)(tok ? tok[row] : row) * lda2; }
};
struct CmpSched {
    int G, c; unsigned pitch2; unsigned col0;
    __device__ __forceinline__ bool next(int i, Unit& u) const {
        const int L = i * G + c; if (L >= 64) return false;
        u.aux = L >> 5; u.pm = L & 31; u.pn = 0; u.boff = (size_t)u.aux * (256u * 2048u * 2u); return true;
    }
    __device__ __forceinline__ unsigned arow(const Unit& u, int r) const {
        const int rho = u.pm * BM + r, bg = rho >> 7; int n = rho & 127; n = n > 126 ? 126 : n;
        const int b = bg >> 2, g = bg & 3;
        return (unsigned)(b * 2048 + 16 * n) * pitch2 + (col0 + (unsigned)u.aux * 256u + (unsigned)g * 64u) * 2u;
    }
};

__device__ __forceinline__ unsigned cvt_pk_bf16(float lo, float hi) { unsigned r; asm volatile("v_cvt_pk_bf16_f32 %0, %1, %2" : "=v"(r) : "v"(lo), "v"(hi)); return r; }

template <class T, class = void> struct has_prefetch { static constexpr bool value = false; };
template <class T> struct has_prefetch<T, decltype((void)&T::prefetch)> { static constexpr bool value = true; };
template <class Epi, class Sched, bool ALIGN_EPI, bool I8 = false>
__device__ __forceinline__ void gemm_phase(PG8_LAS unsigned char* lds, const Gemm g, const Sched& S, const Epi& E) {
    const int tid = threadIdx.x, wid = __builtin_amdgcn_readfirstlane(tid >> 6), lane = tid & 63, wr = wid >> 2, wc = wid & 3, fr = lane & 15, fq = lane >> 4;
    const int nt = g.nt; const unsigned rowB = g.rowB;
    int Rr[2], Cc[2]; unsigned voffB[2];
#pragma unroll
    for (int i = 0; i < 2; ++i) { int R, C; stage_rc(tid * 16 + i * 8192, R, C); const int Rb = (R & ~31) + perm32(R & 31); Rr[i] = R; Cc[i] = C; voffB[i] = (unsigned)Rb * rowB + (unsigned)C * 2u; }
    const size_t kstepB = (size_t)(BK * 2);
    const size_t kstepA = (size_t)g.kstepA;
    const size_t hstepB = (size_t)HALF * rowB;
    const unsigned ldsw = (unsigned)wid * 1024u;
    const int aoff = lds_byte(wr * 64 + fr, fq * 8), boff = lds_byte(wc * 32 + fr, fq * 8);
#define PG8_SA(b, h) (((b) * 2 + (h)) * HTB)
#define PG8_SB(b, h) ((4 + (b) * 2 + (h)) * HTB)
#define PG8_STAGE(bufoff, gbase, voff) do { _Pragma("unroll") for (int _i = 0; _i < 2; ++_i) \
        __builtin_amdgcn_global_load_lds((const unsigned*)((const char*)(gbase) + (voff)[_i]), (PG8_LAS unsigned*)(lds + (bufoff) + ldsw + _i * 8192), 16, 0, 0); } while (0)
#define PG8_LDA(dst, b, h) do { _Pragma("unroll") for (int m = 0; m < 4; ++m) _Pragma("unroll") for (int k = 0; k < 2; ++k) dst[m][k] = *(const PG8_LAS bf16x8*)(lds + PG8_SA(b, h) + aoff + m * 2048 + k * 1024); } while (0)
#define PG8_LDB(dst, b, h) do { _Pragma("unroll") for (int n = 0; n < 2; ++n) _Pragma("unroll") for (int k = 0; k < 2; ++k) dst[n][k] = *(const PG8_LAS bf16x8*)(lds + PG8_SB(b, h) + boff + n * 2048 + k * 1024); } while (0)
#define PG8_MMA(ai, bj, At, Bt) do { __builtin_amdgcn_s_setprio(1); _Pragma("unroll") for (int m = 0; m < 4; ++m) _Pragma("unroll") for (int n = 0; n < 2; ++n) _Pragma("unroll") for (int k = 0; k < 2; ++k) \
        { if constexpr (I8) acc[ai][bj][m][n] = __builtin_amdgcn_mfma_i32_16x16x64_i8(__builtin_bit_cast(i32x4, Bt[n][k]), __builtin_bit_cast(i32x4, At[m][k]), acc[ai][bj][m][n], 0, 0, 0); \
          else acc[ai][bj][m][n] = __builtin_amdgcn_mfma_f32_16x16x32_bf16(Bt[n][k], At[m][k], acc[ai][bj][m][n], 0, 0, 0); } __builtin_amdgcn_s_setprio(0); } while (0)
#define PG8_WAIT_V(n) asm volatile("s_waitcnt vmcnt(" #n ")" ::: "memory")
#define PG8_WAIT_L(n) asm volatile("s_waitcnt lgkmcnt(" #n ")" ::: "memory")
#define PG8_BAR __builtin_amdgcn_s_barrier()
#define PG8_SCHED __builtin_amdgcn_sched_barrier(0)
    Unit cur, nxt; int ui = 0;
    if (!S.next(0, cur)) return;
    typedef typename AccSel<I8>::T AccT;
    AccT acc[2][2][4][2];
#pragma unroll
    for (int a = 0; a < 2; ++a)
#pragma unroll
        for (int b = 0; b < 2; ++b)
#pragma unroll
            for (int m = 0; m < 4; ++m)
#pragma unroll
                for (int n = 0; n < 2; ++n) acc[a][b][m][n] = AccT{};
    bf16x8 At[4][2], B0[2][2], B1[2][2];
    unsigned vA0[2], vA1[2], vN0[2], vN1[2];
#pragma unroll
    for (int i = 0; i < 2; ++i) { vA0[i] = S.arow(cur, Rr[i]) + (unsigned)Cc[i] * 2u; vA1[i] = S.arow(cur, HALF + Rr[i]) + (unsigned)Cc[i] * 2u; }
    const char* gA = (const char*)g.A; const char* cB = (const char*)g.Bt + cur.boff;
    if constexpr (has_prefetch<Epi>::value) E.prefetch(cur, 0, wid, lane);
    PG8_STAGE(PG8_SB(0, 0), cB, voffB); PG8_STAGE(PG8_SB(0, 1), cB + hstepB, voffB); PG8_STAGE(PG8_SA(0, 0), gA, vA0); PG8_STAGE(PG8_SA(0, 1), gA, vA1);
    if (wr == 1) PG8_BAR;
    PG8_WAIT_V(2); PG8_BAR;
    PG8_STAGE(PG8_SB(1, 0), cB + kstepB, voffB); PG8_STAGE(PG8_SA(1, 0), gA + kstepA, vA0); PG8_STAGE(PG8_SB(1, 1), cB + hstepB + kstepB, voffB);
    PG8_WAIT_V(6); PG8_BAR;
    for (;;) {
        const bool has_next = S.next(ui + 1, nxt);
        const char* nB = has_next ? (const char*)g.Bt + nxt.boff : cB;
#pragma unroll
        for (int i = 0; i < 2; ++i) { vN0[i] = has_next ? S.arow(nxt, Rr[i]) + (unsigned)Cc[i] * 2u : vA0[i]; vN1[i] = has_next ? S.arow(nxt, HALF + Rr[i]) + (unsigned)Cc[i] * 2u : vA1[i]; }
        for (int t = 0; t < nt; t += 2) {
            const bool last = (t == nt - 2);
            const char* a1 = gA + (size_t)(t + 1) * kstepA;
            const char* a2 = last ? gA : gA + (size_t)(t + 2) * kstepA; const char* b2 = last ? nB : cB + (size_t)(t + 2) * kstepB;
            const char* a3 = a2 + kstepA; const char* b3 = b2 + kstepB;
            unsigned o0[2], o1[2];
#pragma unroll
            for (int i = 0; i < 2; ++i) { o0[i] = last ? vN0[i] : vA0[i]; o1[i] = last ? vN1[i] : vA1[i]; }
            PG8_LDB(B0, 0, 0); PG8_LDB(B1, 0, 1); PG8_SCHED; PG8_LDA(At, 0, 0); PG8_STAGE(PG8_SA(1, 1), a1, vA1);
            PG8_WAIT_V(8); PG8_WAIT_L(0); PG8_BAR; PG8_MMA(0, 0, At, B0); PG8_MMA(0, 1, At, B1); PG8_BAR; PG8_SCHED;
            PG8_LDA(At, 0, 1); PG8_STAGE(PG8_SB(0, 0), b2, voffB); PG8_STAGE(PG8_SB(0, 1), b2 + hstepB, voffB); PG8_STAGE(PG8_SA(0, 0), a2, o0);
            PG8_WAIT_V(8); PG8_WAIT_L(0); PG8_BAR; PG8_MMA(1, 0, At, B0); PG8_MMA(1, 1, At, B1); PG8_BAR; PG8_SCHED;
            PG8_LDB(B0, 1, 0); PG8_LDB(B1, 1, 1); PG8_SCHED; PG8_LDA(At, 1, 0); PG8_STAGE(PG8_SA(0, 1), a2, o1);
            PG8_WAIT_V(8); PG8_WAIT_L(0); PG8_BAR; PG8_MMA(0, 0, At, B0); PG8_MMA(0, 1, At, B1); PG8_BAR; PG8_SCHED;
            PG8_LDA(At, 1, 1); PG8_STAGE(PG8_SB(1, 0), b3, voffB); PG8_STAGE(PG8_SB(1, 1), b3 + hstepB, voffB); PG8_STAGE(PG8_SA(1, 0), a3, o0);
            PG8_WAIT_V(8); PG8_WAIT_L(0); PG8_BAR; PG8_MMA(1, 0, At, B0); PG8_MMA(1, 1, At, B1); PG8_BAR; PG8_SCHED;
        }
        if constexpr (ALIGN_EPI) { if (wr == 0) PG8_BAR; }
        if constexpr (has_prefetch<Epi>::value) E.run(acc, cur, wr, wc, fr, fq, ui & 1); else E(acc, cur, wr, wc, fr, fq);
        if (!has_next) break;
#pragma unroll
        for (int a = 0; a < 2; ++a)
#pragma unroll
            for (int b = 0; b < 2; ++b)
#pragma unroll
                for (int m = 0; m < 4; ++m)
#pragma unroll
                    for (int n = 0; n < 2; ++n) acc[a][b][m][n] = AccT{};
        cur = nxt; cB = nB; ++ui;
        if constexpr (has_prefetch<Epi>::value) E.prefetch(cur, ui & 1, wid, lane);
#pragma unroll
        for (int i = 0; i < 2; ++i) { vA0[i] = vN0[i]; vA1[i] = vN1[i]; }
        if constexpr (ALIGN_EPI) { if (wr == 1) PG8_BAR; }
    }
    PG8_WAIT_V(0);
    if constexpr (!ALIGN_EPI) { if (wr == 0) PG8_BAR; }
    PG8_BAR;
#undef PG8_SA
#undef PG8_SB
#undef PG8_STAGE
#undef PG8_LDA
#undef PG8_LDB
#undef PG8_MMA
#undef PG8_WAIT_V
#undef PG8_WAIT_L
#undef PG8_BAR
#undef PG8_SCHED
}
}
namespace epi {
using pg8::f32x4; using pg8::u32x4; using pg8::Unit; using pg8::bf16_t; using pg8::cvt_pk_bf16;
constexpr int BM = 256, HALF = 128;
constexpr float NORM_EPS = 1e-6f;

__device__ __forceinline__ float row_rstd(const float* ssq, int row) {
    const f32x4* p = (const f32x4*)(ssq + (size_t)row * 16);
    const f32x4 a = p[0], b = p[1], c = p[2], d = p[3];
    const float s = ((a[0] + a[1]) + (a[2] + a[3])) + ((b[0] + b[1]) + (b[2] + b[3])) + ((c[0] + c[1]) + (c[2] + c[3])) + ((d[0] + d[1]) + (d[2] + d[3]));
    return __builtin_amdgcn_rsqf(s * (1.0f / 1024.0f) + NORM_EPS);
}
__device__ __forceinline__ void store8(bf16_t* p, const f32x4& v0, const f32x4& v1) {
    u32x4 w; w.x = cvt_pk_bf16(v0[0], v0[1]); w.y = cvt_pk_bf16(v0[2], v0[3]); w.z = cvt_pk_bf16(v1[0], v1[1]); w.w = cvt_pk_bf16(v1[2], v1[3]);
    *(u32x4*)p = w;
}

__device__ __forceinline__ void load8(const bf16_t* p, f32x4& v0, f32x4& v1) {
    const u32x4 w = *(const u32x4*)p;
    v0 = (f32x4){__uint_as_float(w.x << 16), __uint_as_float(w.x & 0xffff0000u), __uint_as_float(w.y << 16), __uint_as_float(w.y & 0xffff0000u)};
    v1 = (f32x4){__uint_as_float(w.z << 16), __uint_as_float(w.z & 0xffff0000u), __uint_as_float(w.w << 16), __uint_as_float(w.w & 0xffff0000u)};
}


typedef unsigned u32x2e __attribute__((ext_vector_type(2)));
typedef float f32x2 __attribute__((ext_vector_type(2)));
constexpr float RMAGIC = 12582912.0f;
__device__ __forceinline__ unsigned pack_magic4(float a, float b, float c, float d) {
    const unsigned p01 = __builtin_amdgcn_perm(__float_as_uint(b), __float_as_uint(a), 0x0c0c0400u), p23 = __builtin_amdgcn_perm(__float_as_uint(d), __float_as_uint(c), 0x04000c0cu);
    return p01 | p23;
}
__device__ __forceinline__ unsigned q4(const f32x4& v, float qs) {
    float q[4];
#pragma unroll
    for (int i = 0; i < 4; ++i) q[i] = __builtin_amdgcn_fmed3f(__builtin_fmaf(v[i], qs, RMAGIC), RMAGIC - 127.0f, RMAGIC + 127.0f);
    return pack_magic4(q[0], q[1], q[2], q[3]);
}
constexpr float PRED_GROW = 1.1f;
struct Pred { signed char* XQ; unsigned long long* ACC; const float* scl_in; float* scl_out; };
__device__ __forceinline__ void acc_add(unsigned long long* p, float ss) {
    const float ip = __builtin_floorf(ss);
    const unsigned long long v = ((unsigned long long)(unsigned)__builtin_fminf(ip, 4.0e9f) << 20) + (unsigned)((ss - ip) * 1048576.0f);
    __hip_atomic_fetch_add(p, v, __ATOMIC_RELAXED, __HIP_MEMORY_SCOPE_AGENT);
}
__device__ __forceinline__ float rstd4(const unsigned long long* acc, int row) { const unsigned long long v = acc[row];
    const float ssum = ((float)(unsigned)(v >> 32) * 4294967296.0f + (float)(unsigned)v) * (1.0f / 1048576.0f); return __builtin_amdgcn_rsqf(ssum * (1.0f / 1024.0f) + NORM_EPS); }

__device__ __forceinline__ float sumsq8(const f32x4& h0, const f32x4& h1) {
    return ((h0[0] * h0[0] + h0[1] * h0[1]) + (h0[2] * h0[2] + h0[3] * h0[3])) + ((h1[0] * h1[0] + h1[1] * h1[1]) + (h1[2] * h1[2] + h1[3] * h1[3]));
}

__device__ __forceinline__ void unpack8w(const u32x4& w, f32x4& v0, f32x4& v1) {
    v0 = (f32x4){__uint_as_float(w.x << 16), __uint_as_float(w.x & 0xffff0000u), __uint_as_float(w.y << 16), __uint_as_float(w.y & 0xffff0000u)};
    v1 = (f32x4){__uint_as_float(w.z << 16), __uint_as_float(w.z & 0xffff0000u), __uint_as_float(w.w << 16), __uint_as_float(w.w & 0xffff0000u)};
}
#define EPI_PRELOAD_H(ai) \
        u32x4 hw_[4][2]; \
        _Pragma("unroll") for (int m = 0; m < 4; ++m) _Pragma("unroll") for (int bj = 0; bj < 2; ++bj) \
            hw_[m][bj] = *(const u32x4*)(H + (size_t)(row0 + (ai) * HALF + m * 16) * 1024 + col0 + bj * HALF);

template <int KIND> struct EpiQKV {
    bf16_t* O; int ldc; const float* ssq; const float* qg; const float* kg; float qscale;
    __device__ __forceinline__ void operator()(const f32x4 (&acc)[2][2][4][2], const Unit& u, int wr, int wc, int fr, int fq) const {
        const float* gain = nullptr; float sc = 1.f; bool sig = false;
        if (KIND == 0) { const int t = u.pn >> 2; if (t == 0) { gain = qg; sc = qscale; } else if (t == 1) { gain = kg; } }
        else { if (u.pn < 4) { gain = qg; sc = qscale; } else if (u.pn == 6) { gain = kg + 64; } else if (u.pn == 8) { gain = kg + 128; } else if (u.pn == 10) { sig = true; } }
        f32x4 gv[2][2];
#pragma unroll
        for (int bj = 0; bj < 2; ++bj)
#pragma unroll
            for (int n = 0; n < 2; ++n) gv[bj][n] = gain ? *(const f32x4*)(gain + 32 * bj + 8 * fq + 4 * n) * sc : (f32x4){1.f, 1.f, 1.f, 1.f};
        const int row0 = u.pm * BM + wr * 64 + fr, col0 = u.pn * BM + wc * 64 + 8 * fq;
#pragma unroll
        for (int ai = 0; ai < 2; ++ai)
#pragma unroll
            for (int m = 0; m < 4; ++m) {
                const int row = row0 + ai * HALF + m * 16;
                const float rs = row_rstd(ssq, row);
                f32x4 v[2][2]; float ss = 0.f;
#pragma unroll
                for (int bj = 0; bj < 2; ++bj)
#pragma unroll
                    for (int n = 0; n < 2; ++n) { v[bj][n] = acc[ai][bj][m][n] * rs; const f32x4 x = v[bj][n]; ss += (x[0] * x[0] + x[1] * x[1]) + (x[2] * x[2] + x[3] * x[3]); }
                if (gain) {
                    ss += __shfl_xor(ss, 16); ss += __shfl_xor(ss, 32);
                    const float r = __builtin_amdgcn_rsqf(ss * (1.0f / 64.0f) + NORM_EPS);
#pragma unroll
                    for (int bj = 0; bj < 2; ++bj)
#pragma unroll
                        for (int n = 0; n < 2; ++n) v[bj][n] = v[bj][n] * r * gv[bj][n];
                }
                if (sig) {
#pragma unroll
                    for (int bj = 0; bj < 2; ++bj)
#pragma unroll
                        for (int n = 0; n < 2; ++n)
#pragma unroll
                            for (int i = 0; i < 4; ++i) v[bj][n][i] = __builtin_amdgcn_rcpf(1.0f + __expf(-v[bj][n][i]));
                }
                bf16_t* rowp = O + (size_t)row * ldc + col0;
#pragma unroll
                for (int bj = 0; bj < 2; ++bj) store8(rowp + 32 * bj, v[bj][0], v[bj][1]);
            }
    }
};

template <bool SLOT> struct EpiSwiGLU {
    bf16_t* O; int ldc; const float* rsrc;
    __device__ __forceinline__ void operator()(const f32x4 (&acc)[2][2][4][2], const Unit& u, int wr, int wc, int fr, int fq) const {
        const int row0 = u.pm * BM + wr * 64 + fr, col0 = u.pn * HALF + wc * 32 + 8 * fq;
#pragma unroll
        for (int ai = 0; ai < 2; ++ai)
#pragma unroll
            for (int m = 0; m < 4; ++m) {
                const int row = row0 + ai * HALF + m * 16;
                const float rs = SLOT ? rsrc[row] : row_rstd(rsrc, row);
                f32x4 o[2];
#pragma unroll
                for (int n = 0; n < 2; ++n)
#pragma unroll
                    for (int i = 0; i < 4; ++i) { const float gt = acc[ai][0][m][n][i] * rs, up = acc[ai][1][m][n][i] * rs; o[n][i] = gt * __builtin_amdgcn_rcpf(1.0f + __expf(-gt)) * up; }
                store8(O + (size_t)row * ldc + col0, o[0], o[1]);
            }
    }
};

struct EpiResid {
    float* H; bf16_t* XB; float* SSQ;
    __device__ __forceinline__ void operator()(const f32x4 (&acc)[2][2][4][2], const Unit& u, int wr, int wc, int fr, int fq) const {
        const int row0 = u.pm * BM + wr * 64 + fr, col0 = u.pn * BM + wc * 32 + 8 * fq;
#pragma unroll
        for (int ai = 0; ai < 2; ++ai)
#pragma unroll
            for (int m = 0; m < 4; ++m) {
                const int row = row0 + ai * HALF + m * 16; float ss = 0.f;
#pragma unroll
                for (int bj = 0; bj < 2; ++bj) {
                    float* hp = H + (size_t)row * 1024 + col0 + bj * HALF;
                    f32x4 h0 = *(const f32x4*)hp, h1 = *(const f32x4*)(hp + 4);
                    h0 = h0 + acc[ai][bj][m][0]; h1 = h1 + acc[ai][bj][m][1];
                    *(f32x4*)hp = h0; *(f32x4*)(hp + 4) = h1;
                    store8(XB + (size_t)row * 1024 + col0 + bj * HALF, h0, h1);
                    ss += (h0[0] * h0[0] + h0[1] * h0[1]) + (h0[2] * h0[2] + h0[3] * h0[3]) + (h1[0] * h1[0] + h1[1] * h1[1]) + (h1[2] * h1[2] + h1[3] * h1[3]);
                }
                ss += __shfl_xor(ss, 16); ss += __shfl_xor(ss, 32);
                if (fq == 0) SSQ[(size_t)row * 16 + u.pn * 4 + wc] = ss;
            }
    }
};

struct EpiPlain {
    bf16_t* O; int ldc;
    __device__ __forceinline__ void operator()(const f32x4 (&acc)[2][2][4][2], const Unit& u, int wr, int wc, int fr, int fq) const {
        const int row0 = u.pm * BM + wr * 64 + fr, col0 = u.pn * BM + wc * 32 + 8 * fq;
#pragma unroll
        for (int ai = 0; ai < 2; ++ai)
#pragma unroll
            for (int m = 0; m < 4; ++m) {
                const int row = row0 + ai * HALF + m * 16;
#pragma unroll
                for (int bj = 0; bj < 2; ++bj) store8(O + (size_t)row * ldc + col0 + bj * HALF, acc[ai][bj][m][0], acc[ai][bj][m][1]);
            }
    }
};

__device__ __forceinline__ float gelu_tanh(float x) {
    const float z = 0.7978845608028654f * (x + 0.044715f * x * x * x);
    const float t = 1.0f - 2.0f * __builtin_amdgcn_rcpf(1.0f + __expf(2.0f * z));
    return 0.5f * x * (1.0f + t);
}
struct EpiGelu {
    bf16_t* O; const float* cb;
    __device__ __forceinline__ void operator()(const f32x4 (&acc)[2][2][4][2], const Unit& u, int wr, int wc, int fr, int fq) const {
        const int row0 = u.pm * BM + wr * 64 + fr, col0 = wc * 32 + 8 * fq;
        bf16_t* base = O + (size_t)u.aux * 8192 * 256; const float* cbp = cb + u.aux * 256;
        f32x4 bv[2][2];
#pragma unroll
        for (int bj = 0; bj < 2; ++bj)
#pragma unroll
            for (int n = 0; n < 2; ++n) bv[bj][n] = *(const f32x4*)(cbp + col0 + bj * HALF + 4 * n);
#pragma unroll
        for (int ai = 0; ai < 2; ++ai)
#pragma unroll
            for (int m = 0; m < 4; ++m) {
                const int row = row0 + ai * HALF + m * 16;
#pragma unroll
                for (int bj = 0; bj < 2; ++bj) {
                    f32x4 v0 = acc[ai][bj][m][0] + bv[bj][0], v1 = acc[ai][bj][m][1] + bv[bj][1];
#pragma unroll
                    for (int i = 0; i < 4; ++i) { v0[i] = gelu_tanh(v0[i]); v1[i] = gelu_tanh(v1[i]); }
                    store8(base + (size_t)row * 256 + col0 + bj * HALF, v0, v1);
                }
            }
    }
};

template <bool PRED> struct EpiSwiGLU8 {
    signed char* O; int ldc; const float* ra; const float* sw; const float* hsc; const unsigned long long* ssq;
    __attribute__((address_space(3))) unsigned char* side0;
    static constexpr int SIDE = 5120;
    __device__ __forceinline__ void prefetch(const Unit& u, int side, int wid, int lane) const {
        if (wid == 0) {
            asm volatile("" : "+v"(lane));
            __attribute__((address_space(3))) unsigned char* sb = side0 + side * SIDE;
            __builtin_amdgcn_global_load_lds((const unsigned*)(sw + (size_t)u.aux * 7168 + u.pn * BM + lane * 4), (__attribute__((address_space(3))) unsigned*)sb, 16, 0, 0);
            __builtin_amdgcn_global_load_lds((const unsigned*)(ra + (size_t)u.pm * BM + lane * 4), (__attribute__((address_space(3))) unsigned*)(sb + 1024), 16, 0, 0);
            if (PRED) {
                __builtin_amdgcn_global_load_lds((const unsigned*)(ssq + (size_t)u.pm * BM + lane * 2), (__attribute__((address_space(3))) unsigned*)(sb + 2048), 16, 0, 0);
                __builtin_amdgcn_global_load_lds((const unsigned*)(ssq + (size_t)u.pm * BM + 128 + lane * 2), (__attribute__((address_space(3))) unsigned*)(sb + 3072), 16, 0, 0); }
            __builtin_amdgcn_global_load_lds((const unsigned*)(hsc + lane), (__attribute__((address_space(3))) unsigned*)(sb + 4096), 4, 0, 0);
        }
    }
    __device__ __forceinline__ void run(const pg8::i32x4 (&acc)[2][2][4][2], const Unit& u, int wr, int wc, int fr, int fq, int side) const {
        const __attribute__((address_space(3))) float* sl = (const __attribute__((address_space(3))) float*)(side0 + side * SIDE);
        const int row0 = u.pm * BM + wr * 64 + fr, col0 = u.pn * HALF + wc * 32 + 8 * fq;
        const int cb = wc * 32 + 8 * fq, rl0 = wr * 64 + fr;
        const float qs = sl[1024 + 2 * u.aux + 1];
        f32x4 c1[2], c2[2];
#pragma unroll
        for (int n = 0; n < 2; ++n) { const f32x4 sg = *(const __attribute__((address_space(3))) f32x4*)(sl + cb + 4 * n), su = *(const __attribute__((address_space(3))) f32x4*)(sl + HALF + cb + 4 * n); c1[n] = sg * (-1.4426950408889634f); c2[n] = sg * su * qs; }
        float rr_[2][4];
#pragma unroll
        for (int ai = 0; ai < 2; ++ai)
#pragma unroll
            for (int m = 0; m < 4; ++m) { const int rl = rl0 + ai * HALF + m * 16;
                if (PRED) { const unsigned long long v = ((const __attribute__((address_space(3))) unsigned long long*)(sl + 512))[rl];
                    const float ssum = ((float)(unsigned)(v >> 32) * 4294967296.0f + (float)(unsigned)v) * (1.0f / 1048576.0f);
                    rr_[ai][m] = sl[256 + rl] * (1.0f / 127.0f) * __builtin_amdgcn_rsqf(ssum * (1.0f / 1024.0f) + NORM_EPS); }
                else rr_[ai][m] = sl[256 + rl]; }
#pragma unroll
        for (int ai = 0; ai < 2; ++ai)
#pragma unroll
            for (int mp = 0; mp < 4; mp += 2) {
                unsigned wp[2][2];
#pragma unroll
                for (int mm = 0; mm < 2; ++mm) { const int m = mp + mm;
                const float r = rr_[ai][m], r2 = r * r;
                unsigned w[2];
#pragma unroll
                for (int n = 0; n < 2; ++n) { float qf[4];
#pragma unroll
                    for (int hh = 0; hh < 2; ++hh) {
                        const f32x2 ag = {(float)acc[ai][0][m][n][2 * hh], (float)acc[ai][0][m][n][2 * hh + 1]}, au = {(float)acc[ai][1][m][n][2 * hh], (float)acc[ai][1][m][n][2 * hh + 1]};
                        const f32x2 k1 = (f32x2){c1[n][2 * hh], c1[n][2 * hh + 1]} * r, k2 = (f32x2){c2[n][2 * hh], c2[n][2 * hh + 1]} * r2;
                        const f32x2 arg = ag * k1;
                        const f32x2 den = (f32x2){__builtin_amdgcn_exp2f(arg[0]), __builtin_amdgcn_exp2f(arg[1])} + 1.0f;
                        const f32x2 sg = {__builtin_amdgcn_rcpf(den[0]), __builtin_amdgcn_rcpf(den[1])};
                        const f32x2 t = (ag * au) * k2;
                        const f32x2 qv = __builtin_elementwise_fma(t, sg, (f32x2){RMAGIC, RMAGIC});
                        qf[2 * hh] = __builtin_amdgcn_fmed3f(qv[0], RMAGIC - 127.0f, RMAGIC + 127.0f); qf[2 * hh + 1] = __builtin_amdgcn_fmed3f(qv[1], RMAGIC - 127.0f, RMAGIC + 127.0f); }
                    w[n] = pack_magic4(qf[0], qf[1], qf[2], qf[3]); }
                wp[mm][0] = w[0]; wp[mm][1] = w[1]; }
                const auto s0 = __builtin_amdgcn_permlane16_swap(wp[0][0], wp[1][0], false, false);
                const auto s1 = __builtin_amdgcn_permlane16_swap(wp[0][1], wp[1][1], false, false);
                const int row = row0 + ai * HALF + (mp + (fq & 1)) * 16;
                *(u32x4*)(O + (size_t)row * ldc + col0 - 8 * (fq & 1)) = (u32x4){s0[0], s1[0], s0[1], s1[1]};
            }
    }
};
template <bool PRED> struct EpiResid8 {
    bf16_t* H; const float* swd; const float* hsc;
    Pred pr;
    __attribute__((address_space(3))) unsigned char* side0;
    static constexpr int SIDE = 5120;
    __device__ __forceinline__ void prefetch(const Unit& u, int side, int wid, int lane) const {
        if (wid == 0) {
            asm volatile("" : "+v"(lane));
            __attribute__((address_space(3))) unsigned char* sb = side0 + side * SIDE;
            __builtin_amdgcn_global_load_lds((const unsigned*)(swd + u.pn * BM + lane * 4), (__attribute__((address_space(3))) unsigned*)sb, 16, 0, 0);
            if (PRED) __builtin_amdgcn_global_load_lds((const unsigned*)(pr.scl_in + (size_t)u.pm * BM + lane * 4), (__attribute__((address_space(3))) unsigned*)(sb + 1024), 16, 0, 0);
            __builtin_amdgcn_global_load_lds((const unsigned*)(hsc + lane), (__attribute__((address_space(3))) unsigned*)(sb + 4096), 4, 0, 0);
        }
    }
    __device__ __forceinline__ void run(const pg8::i32x4 (&acc)[2][2][4][2], const Unit& u, int wr, int wc, int fr, int fq, int side) const {
        const __attribute__((address_space(3))) float* sl = (const __attribute__((address_space(3))) float*)(side0 + side * SIDE);
        const int row0 = u.pm * BM + wr * 64 + fr, col0 = u.pn * BM + wc * 32 + 8 * fq, cb = wc * 32 + 8 * fq, rl0 = wr * 64 + fr;
        const float hs = sl[1024] * (1.0f / 127.0f);
        f32x4 sc[2][2];
#pragma unroll
        for (int bj = 0; bj < 2; ++bj)
#pragma unroll
            for (int n = 0; n < 2; ++n) sc[bj][n] = *(const __attribute__((address_space(3))) f32x4*)(sl + cb + bj * HALF + 4 * n) * hs;
        float sin_[2][4];
        if (PRED) {
#pragma unroll
            for (int ai = 0; ai < 2; ++ai)
#pragma unroll
                for (int m = 0; m < 4; ++m) sin_[ai][m] = sl[256 + rl0 + ai * HALF + m * 16]; }
#pragma unroll
        for (int ai = 0; ai < 2; ++ai) {
        EPI_PRELOAD_H(ai)
#pragma unroll
            for (int m = 0; m < 4; ++m) {
                const int row = row0 + ai * HALF + m * 16;
                float rng = 0.f, qs = 0.f, ss = 0.f;
                if (PRED) { rng = __builtin_fmaxf(sin_[ai][m] * PRED_GROW, 1e-20f); qs = 127.0f * __builtin_amdgcn_rcpf(rng); }
#pragma unroll
                for (int bj = 0; bj < 2; ++bj) {
                    bf16_t* hp = H + (size_t)row * 1024 + col0 + bj * HALF;
                    f32x4 h0, h1; unpack8w(hw_[m][bj], h0, h1);
#pragma unroll
                    for (int i = 0; i < 4; ++i) { h0[i] += (float)acc[ai][bj][m][0][i] * sc[bj][0][i]; h1[i] += (float)acc[ai][bj][m][1][i] * sc[bj][1][i]; }
                    store8(hp, h0, h1);
                    if (PRED) { ss += sumsq8(h0, h1); *(u32x2e*)(pr.XQ + (size_t)row * 1024 + col0 + bj * HALF) = (u32x2e){q4(h0, qs), q4(h1, qs)}; }
                }
                if (PRED) { ss += __shfl_xor(ss, 16); ss += __shfl_xor(ss, 32);
                    if (fq == 0) { acc_add(pr.ACC + row, ss); if (u.pn == 0 && wc == 0) pr.scl_out[row] = rng; } }
            }
        }
    }
};
struct EpiPlain8 {
    bf16_t* O; int ldc; const float* swd; const float* hsc;
    __attribute__((address_space(3))) unsigned char* side0;
    static constexpr int SIDE = 5120;
    __device__ __forceinline__ void prefetch(const Unit& u, int side, int wid, int lane) const {
        if (wid == 0) {
            asm volatile("" : "+v"(lane));
            __attribute__((address_space(3))) unsigned char* sb = side0 + side * SIDE;
            __builtin_amdgcn_global_load_lds((const unsigned*)(swd + (size_t)u.aux * 1024 + u.pn * BM + lane * 4), (__attribute__((address_space(3))) unsigned*)sb, 16, 0, 0);
            __builtin_amdgcn_global_load_lds((const unsigned*)(hsc + lane), (__attribute__((address_space(3))) unsigned*)(sb + 4096), 4, 0, 0);
        }
    }
    __device__ __forceinline__ void run(const pg8::i32x4 (&acc)[2][2][4][2], const Unit& u, int wr, int wc, int fr, int fq, int side) const {
        const __attribute__((address_space(3))) float* sl = (const __attribute__((address_space(3))) float*)(side0 + side * SIDE);
        const int row0 = u.pm * BM + wr * 64 + fr, col0 = u.pn * BM + wc * 32 + 8 * fq, cb = wc * 32 + 8 * fq;
        const float hs = sl[1024 + 2 * u.aux] * (1.0f / 127.0f);
        f32x4 sc[2][2];
#pragma unroll
        for (int bj = 0; bj < 2; ++bj)
#pragma unroll
            for (int n = 0; n < 2; ++n) sc[bj][n] = *(const __attribute__((address_space(3))) f32x4*)(sl + cb + bj * HALF + 4 * n) * hs;
#pragma unroll
        for (int ai = 0; ai < 2; ++ai)
#pragma unroll
            for (int m = 0; m < 4; ++m) {
                const int row = row0 + ai * HALF + m * 16;
#pragma unroll
                for (int bj = 0; bj < 2; ++bj) { f32x4 v0, v1;
#pragma unroll
                    for (int i = 0; i < 4; ++i) { v0[i] = (float)acc[ai][bj][m][0][i] * sc[bj][0][i]; v1[i] = (float)acc[ai][bj][m][1][i] * sc[bj][1][i]; }
                    store8(O + (size_t)row * ldc + col0 + bj * HALF, v0, v1); }
            }
    }
};

template <int KIND, bool PRED> struct EpiQKV8 {
    bf16_t* O; int ldc; const float* ra; const float* sw; const float* qg; const float* kg; float qscale; const unsigned long long* ssq;
    __attribute__((address_space(3))) unsigned char* side0;
    static constexpr int SIDE = 5120;
    __device__ __forceinline__ const float* gain_of(const Unit& u, float& sc, bool& sig) const {
        const float* gain = nullptr; sc = 1.f; sig = false;
        if (KIND == 0) { const int t = u.pn >> 2; if (t == 0) { gain = qg; sc = qscale; } else if (t == 1) { gain = kg; } }
        else { if (u.pn < 4) { gain = qg; sc = qscale; } else if (u.pn == 6) { gain = kg + 64; } else if (u.pn == 8) { gain = kg + 128; } else if (u.pn == 10) { sig = true; } }
        return gain;
    }
    __device__ __forceinline__ void prefetch(const Unit& u, int side, int wid, int lane) const {
        if (wid == 0) {
            asm volatile("" : "+v"(lane));
            __attribute__((address_space(3))) unsigned char* sb = side0 + side * SIDE;
            __builtin_amdgcn_global_load_lds((const unsigned*)(sw + u.pn * BM + lane * 4), (__attribute__((address_space(3))) unsigned*)sb, 16, 0, 0);
            __builtin_amdgcn_global_load_lds((const unsigned*)(ra + (size_t)u.pm * BM + lane * 4), (__attribute__((address_space(3))) unsigned*)(sb + 1024), 16, 0, 0);
            if (PRED) {
                __builtin_amdgcn_global_load_lds((const unsigned*)(ssq + (size_t)u.pm * BM + lane * 2), (__attribute__((address_space(3))) unsigned*)(sb + 2048), 16, 0, 0);
                __builtin_amdgcn_global_load_lds((const unsigned*)(ssq + (size_t)u.pm * BM + 128 + lane * 2), (__attribute__((address_space(3))) unsigned*)(sb + 3072), 16, 0, 0); }
            float sc; bool sig; const float* gain = gain_of(u, sc, sig);
            if (gain) __builtin_amdgcn_global_load_lds((const unsigned*)(gain + lane), (__attribute__((address_space(3))) unsigned*)(sb + 4096), 4, 0, 0);
        }
    }
    __device__ __forceinline__ void run(const pg8::i32x4 (&acc)[2][2][4][2], const Unit& u, int wr, int wc, int fr, int fq, int side) const {
        const __attribute__((address_space(3))) float* sl = (const __attribute__((address_space(3))) float*)(side0 + side * SIDE);
        float sc; bool sig; const float* gain = gain_of(u, sc, sig);
        f32x4 gv[2][2], sv[2][2];
        const int cb = wc * 32 + 8 * fq, rl0 = wr * 64 + fr;
#pragma unroll
        for (int bj = 0; bj < 2; ++bj)
#pragma unroll
            for (int n = 0; n < 2; ++n) { gv[bj][n] = gain ? *(const __attribute__((address_space(3))) f32x4*)(sl + 1024 + 32 * bj + 8 * fq + 4 * n) * sc : (f32x4){1.f, 1.f, 1.f, 1.f}; sv[bj][n] = *(const __attribute__((address_space(3))) f32x4*)(sl + cb + bj * HALF + 4 * n); }
        const int row0 = u.pm * BM + wr * 64 + fr, col0 = u.pn * BM + wc * 64 + 8 * fq;
        float rr_[2][4];
#pragma unroll
        for (int ai = 0; ai < 2; ++ai)
#pragma unroll
            for (int m = 0; m < 4; ++m) { const int rl = rl0 + ai * HALF + m * 16;
                if (PRED) { const unsigned long long v = ((const __attribute__((address_space(3))) unsigned long long*)(sl + 512))[rl];
                    const float ssum = ((float)(unsigned)(v >> 32) * 4294967296.0f + (float)(unsigned)v) * (1.0f / 1048576.0f);
                    rr_[ai][m] = sl[256 + rl] * (1.0f / 127.0f) * __builtin_amdgcn_rsqf(ssum * (1.0f / 1024.0f) + NORM_EPS); }
                else rr_[ai][m] = sl[256 + rl]; }
#pragma unroll
        for (int ai = 0; ai < 2; ++ai)
#pragma unroll
            for (int m = 0; m < 4; ++m) {
                const int row = row0 + ai * HALF + m * 16;
                const float rs = rr_[ai][m];
                f32x4 v[2][2]; float ss = 0.f;
#pragma unroll
                for (int bj = 0; bj < 2; ++bj)
#pragma unroll
                    for (int n = 0; n < 2; ++n) {
#pragma unroll
                        for (int i = 0; i < 4; ++i) v[bj][n][i] = (float)acc[ai][bj][m][n][i] * (rs * sv[bj][n][i]);
                        const f32x4 x = v[bj][n]; ss += (x[0] * x[0] + x[1] * x[1]) + (x[2] * x[2] + x[3] * x[3]); }
                if (gain) {
                    ss += __shfl_xor(ss, 16); ss += __shfl_xor(ss, 32);
                    const float r = __builtin_amdgcn_rsqf(ss * (1.0f / 64.0f) + NORM_EPS);
#pragma unroll
                    for (int bj = 0; bj < 2; ++bj)
#pragma unroll
                        for (int n = 0; n < 2; ++n) v[bj][n] = v[bj][n] * r * gv[bj][n];
                }
                if (sig) {
#pragma unroll
                    for (int bj = 0; bj < 2; ++bj)
#pragma unroll
                        for (int n = 0; n < 2; ++n)
#pragma unroll
                            for (int i = 0; i < 4; ++i) v[bj][n][i] = __builtin_amdgcn_rcpf(1.0f + __expf(-v[bj][n][i]));
                }
                bf16_t* rowp = O + (size_t)row * ldc + col0;
#pragma unroll
                for (int bj = 0; bj < 2; ++bj) store8(rowp + 32 * bj, v[bj][0], v[bj][1]);
            }
    }
};
template <bool PRED> struct EpiResidLean {
    bf16_t* H;
    Pred pr;
    __device__ __forceinline__ void operator()(const f32x4 (&acc)[2][2][4][2], const Unit& u, int wr, int wc, int fr, int fq) const {
        const int row0 = u.pm * BM + wr * 64 + fr, col0 = u.pn * BM + wc * 32 + 8 * fq;
        float sin_[2][4];
        if (PRED) {
#pragma unroll
            for (int ai = 0; ai < 2; ++ai)
#pragma unroll
                for (int m = 0; m < 4; ++m) sin_[ai][m] = pr.scl_in[row0 + ai * HALF + m * 16]; }
#pragma unroll
        for (int ai = 0; ai < 2; ++ai) {
        EPI_PRELOAD_H(ai)
#pragma unroll
            for (int m = 0; m < 4; ++m) {
                const int row = row0 + ai * HALF + m * 16;
                float rng = 0.f, qs = 0.f, ss = 0.f;
                if (PRED) { rng = __builtin_fmaxf(sin_[ai][m] * PRED_GROW, 1e-20f); qs = 127.0f * __builtin_amdgcn_rcpf(rng); }
#pragma unroll
                for (int bj = 0; bj < 2; ++bj) {
                    bf16_t* hp = H + (size_t)row * 1024 + col0 + bj * HALF;
                    f32x4 h0, h1; unpack8w(hw_[m][bj], h0, h1);
                    h0 = h0 + acc[ai][bj][m][0]; h1 = h1 + acc[ai][bj][m][1];
                    store8(hp, h0, h1);
                    if (PRED) { ss += sumsq8(h0, h1); *(u32x2e*)(pr.XQ + (size_t)row * 1024 + col0 + bj * HALF) = (u32x2e){q4(h0, qs), q4(h1, qs)}; }
                }
                if (PRED) { ss += __shfl_xor(ss, 16); ss += __shfl_xor(ss, 32);
                    if (fq == 0) { acc_add(pr.ACC + row, ss); if (u.pn == 0 && wc == 0) pr.scl_out[row] = rng; } }
            }
        }
    }
};
template <bool PRED> struct EpiResidLean8 {
    bf16_t* H; const float* sw; float sa;
    Pred pr;
    __attribute__((address_space(3))) unsigned char* side0;
    static constexpr int SIDE = 5120;
    __device__ __forceinline__ void prefetch(const Unit& u, int side, int wid, int lane) const {
        if (wid == 0) {
            asm volatile("" : "+v"(lane));
            __attribute__((address_space(3))) unsigned char* sb = side0 + side * SIDE;
            __builtin_amdgcn_global_load_lds((const unsigned*)(sw + u.pn * BM + lane * 4), (__attribute__((address_space(3))) unsigned*)sb, 16, 0, 0);
            if (PRED) __builtin_amdgcn_global_load_lds((const unsigned*)(pr.scl_in + (size_t)u.pm * BM + lane * 4), (__attribute__((address_space(3))) unsigned*)(sb + 1024), 16, 0, 0);
        }
    }
    __device__ __forceinline__ void run(const pg8::i32x4 (&acc)[2][2][4][2], const Unit& u, int wr, int wc, int fr, int fq, int side) const {
        const __attribute__((address_space(3))) float* sl = (const __attribute__((address_space(3))) float*)(side0 + side * SIDE);
        const int row0 = u.pm * BM + wr * 64 + fr, col0 = u.pn * BM + wc * 32 + 8 * fq, cb = wc * 32 + 8 * fq, rl0 = wr * 64 + fr;
        f32x4 sc[2][2];
#pragma unroll
        for (int bj = 0; bj < 2; ++bj)
#pragma unroll
            for (int n = 0; n < 2; ++n) sc[bj][n] = *(const __attribute__((address_space(3))) f32x4*)(sl + cb + bj * HALF + 4 * n) * sa;
        float sin_[2][4];
        if (PRED) {
#pragma unroll
            for (int ai = 0; ai < 2; ++ai)
#pragma unroll
                for (int m = 0; m < 4; ++m) sin_[ai][m] = sl[256 + rl0 + ai * HALF + m * 16]; }
#pragma unroll
        for (int ai = 0; ai < 2; ++ai) {
        EPI_PRELOAD_H(ai)
#pragma unroll
            for (int m = 0; m < 4; ++m) {
                const int row = row0 + ai * HALF + m * 16;
                float rng = 0.f, qs = 0.f, ss = 0.f;
                if (PRED) { rng = __builtin_fmaxf(sin_[ai][m] * PRED_GROW, 1e-20f); qs = 127.0f * __builtin_amdgcn_rcpf(rng); }
#pragma unroll
                for (int bj = 0; bj < 2; ++bj) {
                    bf16_t* hp = H + (size_t)row * 1024 + col0 + bj * HALF;
                    f32x4 h0, h1; unpack8w(hw_[m][bj], h0, h1);
#pragma unroll
                    for (int i = 0; i < 4; ++i) { h0[i] += (float)acc[ai][bj][m][0][i] * sc[bj][0][i]; h1[i] += (float)acc[ai][bj][m][1][i] * sc[bj][1][i]; }
                    store8(hp, h0, h1);
                    if (PRED) { ss += sumsq8(h0, h1); *(u32x2e*)(pr.XQ + (size_t)row * 1024 + col0 + bj * HALF) = (u32x2e){q4(h0, qs), q4(h1, qs)}; }
                }
                if (PRED) { ss += __shfl_xor(ss, 16); ss += __shfl_xor(ss, 32);
                    if (fq == 0) { acc_add(pr.ACC + row, ss); if (u.pn == 0 && wc == 0) pr.scl_out[row] = rng; } }
            }
        }
    }
};
}
constexpr int NWAVES = 8;
constexpr int T = 32768, S = 2048, NB = 16, D = 1024, FF = 3584, NE = 8;
constexpr int NIN = 58;
constexpr size_t MiB = 1u << 20;
constexpr float LOG2E = 1.4426950408889634f;
constexpr float C2 = 0.125f * LOG2E;
constexpr int SLOT_CAP = 65536 + NE * 256;
constexpr size_t WS_CTL = 0, CTL_ZERO_BYTES = 2 * MiB;
constexpr size_t WS_SSQ = 1 * MiB;
constexpr size_t WS_ROUTE = 3 * MiB;
constexpr size_t WS_SLOT = 3 * MiB + 512 * 1024;
constexpr size_t WS_TOK = 4 * MiB;
constexpr size_t WS_RSS = 4 * MiB + 512 * 1024;
constexpr size_t WS_CNT = 5 * MiB;
constexpr size_t WS_META = 5 * MiB + 16 * 1024;
constexpr size_t WS_RST = 5 * MiB + 64 * 1024;
constexpr size_t WS_KM = 6 * MiB;
constexpr size_t WS_SEL = 6 * MiB + 512 * 1024;
constexpr size_t WS_CB = 7 * MiB;
constexpr size_t WS_KCMP = 8 * MiB, WS_VCMP = 9 * MiB;
constexpr size_t WS_HID = 10 * MiB;
constexpr size_t WS_XB = 32 * MiB;
constexpr size_t WS_WIN = 96 * MiB, WS_WOUT = 102 * MiB, WS_CW1 = 104 * MiB, WS_WFF = 106 * MiB;
constexpr size_t WFF_GU_BYTES = (size_t)7168 * 1024 * 2, WFF_DN_BYTES = (size_t)1024 * 3584 * 2;
constexpr size_t WS_BIG = 276 * MiB;
constexpr size_t WS_QKV = WS_BIG;
constexpr size_t WS_AO = WS_BIG + 192 * MiB;
constexpr size_t WS_TMP = WS_BIG + 256 * MiB;
constexpr size_t WS_HB = WS_BIG;
constexpr size_t WS_Y = 740 * MiB;
constexpr size_t WS_XQ = 872 * MiB;
constexpr size_t WS_END = 904 * MiB;
constexpr size_t WS_XQS = 512 * MiB;
static_assert(WS_BIG + (size_t)SLOT_CAP * FF <= WS_XQS && WS_XQS + (size_t)SLOT_CAP * 1024 <= 740 * MiB, "slot-ordered rows fit");
constexpr size_t WS_SW = 18 * MiB;
constexpr size_t WS_SWD = 18 * MiB + 229376, WS_HSC = 18 * MiB + 229376 + 32768;
constexpr size_t WS_SWI = 18 * MiB + 327680;
constexpr size_t CT_CMAXW0 = 720896, CT_CMAXW1 = 737280, CT_CMAXW2 = 753664, CT_CMAXW3 = 770048;
constexpr size_t WS_SWO = 18 * MiB + 344064;
constexpr size_t CT_CMAXO0 = 667648, CT_CMAXO3 = 671744;
constexpr size_t CT_CMAXD0 = 589824, CT_CMAXD1 = 593920, CT_CMAXD2 = 626688, CT_CMAXD3 = 630784;
constexpr size_t CT_CMAX0 = 65536, CT_CMAX1 = 98304, CT_CMAX2 = 327680, CT_CMAX3 = 360448;
static_assert(WS_WFF + NE * (WFF_GU_BYTES + WFF_DN_BYTES) <= WS_BIG, "weights fit");
static_assert(WS_HB + (size_t)SLOT_CAP * FF * 2 <= WS_Y && WS_Y + (size_t)SLOT_CAP * 1024 * 2 <= WS_END, "moe buffers fit");
static_assert(WS_TMP + (size_t)T * 1024 * 4 <= WS_Y, "tmp fits");
constexpr int CW_BAR = 4096;
constexpr int RING_BYTES = 131072;
constexpr int MISC_OFF = RING_BYTES + 320;
constexpr int LDS_BYTES = 147456;

#define GAS __attribute__((address_space(1)))
#define LAS __attribute__((address_space(3)))
typedef unsigned short bf16;
typedef unsigned v4u __attribute__((ext_vector_type(4)));
typedef unsigned v2u __attribute__((ext_vector_type(2)));
typedef float f32x4 __attribute__((ext_vector_type(4)));
typedef GAS unsigned gu32;
#define RLX_AGENT __ATOMIC_RELAXED, __HIP_MEMORY_SCOPE_AGENT
__device__ __forceinline__ unsigned pk2(float lo, float hi) { return pg8::cvt_pk_bf16(lo, hi); }
__device__ __forceinline__ float bf_lo(unsigned w) { return __uint_as_float(w << 16); }
__device__ __forceinline__ float bf_hi(unsigned w) { return __uint_as_float(w & 0xffff0000u); }
__device__ __forceinline__ float bf1(bf16 v) { return __uint_as_float((unsigned)v << 16); }
__device__ __forceinline__ float wave_sum(float v) {
#pragma unroll
    for (int o = 1; o < 64; o <<= 1) v += __shfl_xor(v, o);
    return v;
}
#define XB_TMO      128
#define XB_XCNT(j)  (256  + 64 * (j))
#define XB_XSUB(j)  (1280 + 64 * (j))
#define XB_XGEN(j)  (2304 + 64 * (j))
#define XB_TOP      3328
#define XB_TOPGEN   3392
#define XCD_BAR_WORDS 3456
#define XB_SPIN_CAP (1u << 18)

__device__ __forceinline__ unsigned xb_ld(unsigned* p)              { return __hip_atomic_load(p, __ATOMIC_RELAXED, __HIP_MEMORY_SCOPE_AGENT); }
__device__ __forceinline__ unsigned xb_add(unsigned* p, unsigned v) { return __hip_atomic_fetch_add(p, v, __ATOMIC_RELAXED, __HIP_MEMORY_SCOPE_AGENT); }
__device__ __forceinline__ unsigned xb_xcc_id() { return (unsigned)__builtin_amdgcn_s_getreg((3 << 11) | 20) & 0xFu; }
#define XB_SPIN(cond, bar) do { unsigned _sp = 0; while (cond) { __builtin_amdgcn_s_sleep(1); \
    if ((++_sp & 255u) == 0u) { if (xb_ld(&(bar)[XB_TMO])) break; if (_sp > XB_SPIN_CAP) { atomicAdd(&(bar)[XB_TMO], 1u); break; } } } } while (0)

struct XcdBarrier {
    unsigned* bar; unsigned x;
    volatile LAS unsigned* st;
};

__device__ __forceinline__ XcdBarrier xcd_barrier_post(unsigned* bar, volatile LAS unsigned* st) {
    XcdBarrier b; b.bar = bar; b.x = xb_xcc_id(); b.st = st;
    if (threadIdx.x == 0) (void)xb_add(&bar[XB_XCNT(b.x)], 1u);
    return b;
}
__device__ __forceinline__ void xcd_barrier_complete(unsigned* bar, unsigned x, unsigned& nloc, unsigned& nx) {
    const unsigned G = gridDim.x * gridDim.y * gridDim.z;
    unsigned sum, cnt, mine, sp = 0u;
    for (;;) {
        sum = 0u; cnt = 0u; mine = 0u;
#pragma unroll
        for (unsigned j = 0; j < 16; ++j) { const unsigned c = xb_ld(&bar[XB_XCNT(j)]); sum += c; cnt += (c > 0u) ? 1u : 0u; mine = (j == x) ? c : mine; }
        if (sum == G) break;
        __builtin_amdgcn_s_sleep(1);
        if ((++sp & 255u) == 0u) { if (xb_ld(&bar[XB_TMO])) break; if (sp > XB_SPIN_CAP) { atomicAdd(&bar[XB_TMO], 1u); break; } }
    }
    nloc = mine > 0u ? mine : 1u; nx = cnt > 0u ? cnt : 1u;
}

__device__ __forceinline__ void xcd_barrier(const XcdBarrier& b) {
    asm volatile("s_waitcnt vmcnt(0)" ::: "memory");
    __syncthreads();
    if (threadIdx.x == 0) {
        unsigned* bar = b.bar;
        __builtin_amdgcn_s_waitcnt(0);
        unsigned nloc = b.st[0], nx = b.st[1];
        if (nloc == 0u) { xcd_barrier_complete(bar, b.x, nloc, nx); b.st[0] = nloc; b.st[1] = nx; }
        const unsigned old = xb_add(&bar[XB_XSUB(b.x)], 1u);
        const unsigned gen = old / nloc;
        if (old + 1u == (gen + 1u) * nloc) {
            __builtin_amdgcn_fence(__ATOMIC_RELEASE, "agent");
            asm volatile("s_waitcnt vmcnt(0)" ::: "memory");
            const unsigned og = xb_add(&bar[XB_TOP], 1u);
            const unsigned tg = og / nx;
            if (og + 1u == (tg + 1u) * nx) xb_add(&bar[XB_TOPGEN], 1u);
            else XB_SPIN(xb_ld(&bar[XB_TOPGEN]) == tg, bar);
            __builtin_amdgcn_fence(__ATOMIC_ACQUIRE, "agent");
            xb_add(&bar[XB_XGEN(b.x)], 1u);
            asm volatile("s_waitcnt vmcnt(0)" ::: "memory");
        } else {
            XB_SPIN(xb_ld(&bar[XB_XGEN(b.x)]) == gen, bar);
            __builtin_amdgcn_fence(__ATOMIC_ACQUIRE, "agent");
            asm volatile("s_waitcnt vmcnt(0)" ::: "memory");
        }
    }
    __syncthreads();
}
struct Ctx { int tid, lane, wave, bid, G, gw, NGW; LAS unsigned char* lds; };

__device__ __forceinline__ void unpack8(const v4u w, f32x4& a, f32x4& b) { a = (f32x4){bf_lo(w.x), bf_hi(w.x), bf_lo(w.y), bf_hi(w.y)}; b = (f32x4){bf_lo(w.z), bf_hi(w.z), bf_lo(w.w), bf_hi(w.w)}; }
__device__ __forceinline__ void load_hrow(const bf16* hrow, f32x4 (&v)[4], int lane) {
    const v4u* p = (const v4u*)hrow + lane;
    const v4u w0 = p[0], w1 = p[64];
    unpack8(w0, v[0], v[1]); unpack8(w1, v[2], v[3]);
}
__device__ __forceinline__ void store_hrow(bf16* hrow, const f32x4 (&v)[4], int lane) {
    v4u* p = (v4u*)hrow + lane;
    v4u w0, w1;
    w0.x = pk2(v[0][0], v[0][1]); w0.y = pk2(v[0][2], v[0][3]); w0.z = pk2(v[1][0], v[1][1]); w0.w = pk2(v[1][2], v[1][3]);
    w1.x = pk2(v[2][0], v[2][1]); w1.y = pk2(v[2][2], v[2][3]); w1.z = pk2(v[3][0], v[3][1]); w1.w = pk2(v[3][2], v[3][3]);
    p[0] = w0; p[64] = w1;
}
__device__ __forceinline__ void load_frow(const float* row, f32x4 (&v)[4], int lane) {
    const f32x4* p = (const f32x4*)row + 2 * lane;
    v[0] = __builtin_nontemporal_load(p); v[1] = __builtin_nontemporal_load(p + 1); v[2] = __builtin_nontemporal_load(p + 128); v[3] = __builtin_nontemporal_load(p + 129);
}
__device__ __forceinline__ void store_frow(float* row, const f32x4 (&v)[4], int lane) {
    f32x4* p = (f32x4*)row + 2 * lane;
    __builtin_nontemporal_store(v[0], p); __builtin_nontemporal_store(v[1], p + 1); __builtin_nontemporal_store(v[2], p + 128); __builtin_nontemporal_store(v[3], p + 129);
}
__device__ __forceinline__ void quant_row(const f32x4 (&v)[4], float amax, float ss, signed char* xq_row, float* ra, int lane);
__device__ __forceinline__ float wave_max(float v);
__device__ __forceinline__ void ph_prep(const Ctx& c, const float* x, bf16* H, signed char* XQ, float* RA) {
    for (int m0 = c.gw * 4; m0 < T; m0 += c.NGW * 4) {
        f32x4 v[4][4];
#pragma unroll
        for (int u = 0; u < 4; ++u) load_frow(x + (size_t)(m0 + u) * D, v[u], c.lane);
#pragma unroll
        for (int u = 0; u < 4; ++u) { const int m = m0 + u; float s = 0.f, am = 0.f;
#pragma unroll
            for (int j = 0; j < 4; ++j) { s += (v[u][j][0] * v[u][j][0] + v[u][j][1] * v[u][j][1]) + (v[u][j][2] * v[u][j][2] + v[u][j][3] * v[u][j][3]);
                am = __builtin_fmaxf(am, __builtin_fmaxf(__builtin_fmaxf(__builtin_fabsf(v[u][j][0]), __builtin_fabsf(v[u][j][1])), __builtin_fmaxf(__builtin_fabsf(v[u][j][2]), __builtin_fabsf(v[u][j][3])))); }
            s = wave_sum(s); am = wave_max(am);
            store_hrow(H + (size_t)m * D, v[u], c.lane);
            quant_row(v[u], am, s, XQ + (size_t)m * D, RA + m, c.lane); }
    }
}

__device__ __forceinline__ int dest_row(int n0, int mode) {
    if (mode == 1) { const int blk = n0 & ~255, np = n0 & 255; return blk + 128 * ((np >> 5) & 1) + 32 * (np >> 6); }
    if (mode == 2) return 256 * (n0 >> 7) + (n0 & 127);
    if (mode == 3) return 256 * (n0 >> 7) + 128 + (n0 & 127);
    return n0;
}
__device__ __forceinline__ void cv_item(const float* W, int ldw, int nvalid, const float* kscale, bf16* WT, int K, int k0, int n0, int drow, LAS float* scr, int lane) {
    const int n = n0 + (lane & 31); const bool ok = n < nvalid;
    const float* src = W + (size_t)(k0 + (lane >> 5)) * ldw + n;
    float v[32];
#pragma unroll
    for (int i = 0; i < 32; ++i) v[i] = ok ? src[(size_t)(2 * i) * ldw] : 0.f;
    if (kscale) {
#pragma unroll
        for (int i = 0; i < 32; ++i) v[i] *= kscale[k0 + 2 * i + (lane >> 5)];
    }
#pragma unroll
    for (int i = 0; i < 32; ++i) scr[(2 * i + (lane >> 5)) * 33 + (lane & 31)] = v[i];
    asm volatile("s_waitcnt lgkmcnt(0)" ::: "memory");
    const int ch = lane & 7;
#pragma unroll
    for (int j = 0; j < 4; ++j) { const int nn = (lane >> 3) + 8 * j; const LAS float* sp = scr + (8 * ch) * 33 + nn;
        v4u o; o.x = pk2(sp[0 * 33], sp[1 * 33]); o.y = pk2(sp[2 * 33], sp[3 * 33]); o.z = pk2(sp[4 * 33], sp[5 * 33]); o.w = pk2(sp[6 * 33], sp[7 * 33]);
        *(v4u*)(WT + (size_t)(drow + nn) * K + k0 + 8 * ch) = o; }
    asm volatile("s_waitcnt lgkmcnt(0)" ::: "memory");
}
__device__ __forceinline__ void cv_matrix(const Ctx& c, const float* W, int K, int ldw, int nvalid, int npad, const float* kscale, bf16* WT, int mode, int& rot) {
    LAS float* scr = (LAS float*)(c.lds + c.wave * 16384);
    const int nblk = npad / 32, nitems = (K / 64) * nblk;
    int first = c.gw - rot; if (first < 0) first += c.NGW;
    for (int it = first; it < nitems; it += c.NGW) { const int kb = it / nblk, nb = it % nblk; cv_item(W, ldw, nvalid, kscale, WT, K, 64 * kb, 32 * nb, dest_row(32 * nb, mode), scr, c.lane); }
    rot = (rot + nitems) % c.NGW;
}
__device__ __forceinline__ void cv_attn_weights(const Ctx& c, const float* w_in, int n_in_cols, int n_in_pad, const float* norm_mix, const float* w_out, bf16* WIN, bf16* WOUT, int& rot) {
    cv_matrix(c, w_in, 1024, n_in_cols, n_in_cols, n_in_pad, norm_mix, WIN, 1, rot);
    cv_matrix(c, w_out, 1024, 1024, 1024, 1024, nullptr, WOUT, 0, rot);
}
__device__ __forceinline__ void cv_ffn_weights(const Ctx& c, const float* wg, const float* wu, const float* wd, const float* norm_ffn, bf16* WFF, int nexp, int& rot) {
    for (int e = 0; e < nexp; ++e) {
        bf16* gu = WFF + (size_t)e * (7168 * 1024); bf16* dn = WFF + (size_t)nexp * (7168 * 1024) + (size_t)e * (1024 * 3584);
        cv_matrix(c, wg + (size_t)e * 1024 * FF, 1024, FF, FF, FF, norm_ffn, gu, 2, rot);
        cv_matrix(c, wu + (size_t)e * 1024 * FF, 1024, FF, FF, FF, norm_ffn, gu, 3, rot);
        cv_matrix(c, wd + (size_t)e * FF * 1024, FF, 1024, 1024, 1024, nullptr, dn, 0, rot);
    }
}


__device__ __forceinline__ float wave_max(float v) {
#pragma unroll
    for (int o = 1; o < 64; o <<= 1) v = __builtin_fmaxf(v, __shfl_xor(v, o));
    return v;
}
__device__ __forceinline__ void cvq_max_item(const float* W, int ldw, int nvalid, const float* kscale, int* CMAX, int k0, int n0, int drow0, int drow1, int lane) {
    const int rsub = lane >> 4, ch = lane & 15, n = n0 + 4 * ch; const bool ok = n < nvalid;
    const float* src = W + (size_t)(k0 + rsub) * ldw + n;
    f32x4 v[16];
#pragma unroll
    for (int j = 0; j < 16; ++j) v[j] = ok ? __builtin_nontemporal_load((const f32x4*)(src + (size_t)(4 * j) * ldw)) : (f32x4){0.f, 0.f, 0.f, 0.f};
    f32x4 m = {0.f, 0.f, 0.f, 0.f};
#pragma unroll
    for (int j = 0; j < 16; ++j) { const float ks = kscale ? kscale[k0 + 4 * j + rsub] : 1.0f;
#pragma unroll
        for (int i = 0; i < 4; ++i) m[i] = __builtin_fmaxf(m[i], __builtin_fabsf(v[j][i] * ks)); }
    const int dr = ((ch >> 3) ? drow1 : drow0) + ((4 * ch) & 31);
#pragma unroll
    for (int i = 0; i < 4; ++i) { float x = m[i]; x = __builtin_fmaxf(x, __shfl_xor(x, 16)); x = __builtin_fmaxf(x, __shfl_xor(x, 32)); if (rsub == 0) atomicMax(CMAX + dr + i, (int)__float_as_uint(x)); }
}
__device__ __forceinline__ void cvq_quant_item(const float* W, int ldw, int nvalid, const float* kscale, const int* CMAX, float* SW, signed char* WQ, int K, int k0, int n0, int drow0, int drow1, LAS unsigned char* scr, int lane, float rng) {
    const int rsub = lane >> 4, ch = lane & 15, n = n0 + 4 * ch; const bool ok = n < nvalid;
    const float* src = W + (size_t)(k0 + rsub) * ldw + n;
    f32x4 v[16];
#pragma unroll
    for (int j = 0; j < 16; ++j) v[j] = ok ? __builtin_nontemporal_load((const f32x4*)(src + (size_t)(4 * j) * ldw)) : (f32x4){0.f, 0.f, 0.f, 0.f};
    const int dr = ((ch >> 3) ? drow1 : drow0) + ((4 * ch) & 31);
    f32x4 inv;
#pragma unroll
    for (int i = 0; i < 4; ++i) { const float cm = rng * __uint_as_float((unsigned)CMAX[dr + i]); inv[i] = cm > 0.f ? 127.0f / cm : 0.f; if (k0 == 0 && rsub == 0) SW[dr + i] = cm * (1.0f / 127.0f); }
    asm volatile("" ::: "memory");
#pragma unroll
    for (int j = 0; j < 16; ++j) { const int kk = 4 * j + rsub; const float ks = kscale ? kscale[k0 + kk] : 1.0f;
#pragma unroll
        for (int i = 0; i < 4; ++i) { int q = (int)__builtin_rintf(v[j][i] * ks * inv[i]); q = q > 127 ? 127 : (q < -127 ? -127 : q); scr[(4 * ch + i) * 80 + kk] = (unsigned char)q; } }
    asm volatile("s_waitcnt lgkmcnt(0)" ::: "memory");
#pragma unroll
    for (int st = 0; st < 4; ++st) { const int r = st * 16 + (lane >> 2), c4 = lane & 3;
        const v4u x = *(const LAS v4u*)(scr + r * 80 + c4 * 16);
        const int drw = ((r >> 5) ? drow1 : drow0) + (r & 31);
        __builtin_nontemporal_store(x, (v4u*)(WQ + (size_t)drw * K + k0 + c4 * 16)); }
    asm volatile("s_waitcnt lgkmcnt(0)" ::: "memory");
}
__device__ __forceinline__ void cvq_matrix(const Ctx& c, const float* W, int K, int ldw, int N, int nvalid, const float* kscale, signed char* WQ, int* CMAX, float* SW, int mode, int pass, int& rot, bool full = false) {
    LAS unsigned char* scr = (LAS unsigned char*)(c.lds + c.wave * 16384);
    const int nblk = N / 64, nitems = (K / 64) * nblk;
    int first = c.gw - rot; if (first < 0) first += c.NGW;
    if (pass == 1) {
        const int kstep = full ? 64 : 512; const int nit1 = (K / kstep) * nblk;
        for (int it = first; it < nit1; it += c.NGW) { const int kb = it / nblk, nb = it % nblk; cvq_max_item(W, ldw, nvalid, kscale, CMAX, kstep * kb, 64 * nb, dest_row(64 * nb, mode), dest_row(64 * nb + 32, mode), c.lane); }
        rot = (rot + nit1) % c.NGW;
        return;
    }
    for (int it = first; it < nitems; it += c.NGW) { const int kb = it / nblk, nb = it % nblk;
        cvq_quant_item(W, ldw, nvalid, kscale, CMAX, SW, WQ, K, 64 * kb, 64 * nb, dest_row(64 * nb, mode), dest_row(64 * nb + 32, mode), scr, c.lane, full ? 1.0f : 1.3f); }
    rot = (rot + nitems) % c.NGW;
}
__device__ __forceinline__ void cvq_ffn(const Ctx& c, const float* wg, const float* wu, const float* wd, const float* norm_ffn, unsigned char* WFF8, int* CMAX, int* CMAXD, float* SW, float* SWD, int nexp, int pass, int& rot) {
    for (int e = 0; e < nexp; ++e) {
        signed char* gu = (signed char*)WFF8 + (size_t)e * 7168 * 1024; signed char* dn = (signed char*)WFF8 + (size_t)nexp * 7168 * 1024 + (size_t)e * 1024 * 3584;
        cvq_matrix(c, wg + (size_t)e * 1024 * FF, 1024, FF, FF, FF, norm_ffn, gu, CMAX + e * 7168, SW + e * 7168, 2, pass, rot);
        cvq_matrix(c, wu + (size_t)e * 1024 * FF, 1024, FF, FF, FF, norm_ffn, gu, CMAX + e * 7168, SW + e * 7168, 3, pass, rot);
        cvq_matrix(c, wd + (size_t)e * FF * 1024, FF, 1024, 1024, 1024, nullptr, dn, CMAXD + e * 1024, SWD + e * 1024, 0, pass, rot);
    }
}
__device__ __forceinline__ void ph_hidden_scale(const Ctx& c, const int* CMAX, float* HSC, int nexp) {
    if (c.gw < nexp) {
        const int* cm = CMAX + c.gw * 7168; float sg = 0.f, su = 0.f;
        for (int i = c.lane; i < 7168; i += 64) { const float v = __uint_as_float((unsigned)cm[i]); if ((i >> 7) & 1) su += v; else sg += v; }
        sg = wave_sum(sg) * (1.0f / 3584.0f); su = wave_sum(su) * (1.0f / 3584.0f);
        float clip = 8.0f * (sg * (1.0f / 0.0875f)) * (su * (1.0f / 0.0875f));
        clip = clip > 1e-20f ? clip : 1e-20f;
        if (c.lane == 0) { HSC[2 * c.gw] = clip; HSC[2 * c.gw + 1] = 127.0f / clip; }
    }
}
__device__ __forceinline__ void quant_row(const f32x4 (&v)[4], float amax, float ss, signed char* xq_row, float* ra, int lane) {
    const float rs = __builtin_amdgcn_rsqf(ss * (1.0f / 1024.0f) + 1e-6f);
    const float sc = amax > 0.f ? 127.0f / amax : 0.f;
    unsigned w[4];
#pragma unroll
    for (int j = 0; j < 4; ++j) { float qf[4];
#pragma unroll
        for (int i = 0; i < 4; ++i) qf[i] = __builtin_amdgcn_fmed3f(__builtin_fmaf(v[j][i], sc, epi::RMAGIC), epi::RMAGIC - 127.0f, epi::RMAGIC + 127.0f);
        w[j] = epi::pack_magic4(qf[0], qf[1], qf[2], qf[3]); }
    v2u* p = (v2u*)xq_row + lane;
    p[0] = (v2u){w[0], w[1]}; p[64] = (v2u){w[2], w[3]};
    if (lane == 0) { *ra = amax * (1.0f / 127.0f) * rs; ra[T] = amax; }
}
__device__ __forceinline__ void ph_quant_rows(const Ctx& c, const bf16* H, signed char* XQ, float* RA) {
    for (int m0 = c.gw * 4; m0 < T; m0 += c.NGW * 4) {
        f32x4 v[4][4];
#pragma unroll
        for (int u = 0; u < 4; ++u) load_hrow(H + (size_t)(m0 + u) * D, v[u], c.lane);
#pragma unroll
        for (int u = 0; u < 4; ++u) { float ss = 0.f, am = 0.f;
#pragma unroll
            for (int j = 0; j < 4; ++j) { ss += (v[u][j][0] * v[u][j][0] + v[u][j][1] * v[u][j][1]) + (v[u][j][2] * v[u][j][2] + v[u][j][3] * v[u][j][3]);
                am = __builtin_fmaxf(am, __builtin_fmaxf(__builtin_fmaxf(__builtin_fabsf(v[u][j][0]), __builtin_fabsf(v[u][j][1])), __builtin_fmaxf(__builtin_fabsf(v[u][j][2]), __builtin_fabsf(v[u][j][3])))); }
            ss = wave_sum(ss); am = wave_max(am);
            quant_row(v[u], am, ss, XQ + (size_t)(m0 + u) * D, RA + m0 + u, c.lane); }
    }
}

__device__ __forceinline__ int rel_bucket(int d) {
    if (d < 16) return d;
    int b = 16;
    b += (d >= 21); b += (d >= 27); b += (d >= 35); b += (d >= 46); b += (d >= 59); b += (d >= 77); b += (d >= 99); b += (d >= 128);
    b += (d >= 166); b += (d >= 216); b += (d >= 280); b += (d >= 363); b += (d >= 470); b += (d >= 609); b += (d >= 790);
    return b;
}
__device__ __forceinline__ void build_bias_tbl(LAS float* tbl, const float* rel_bias, int col, int tid) {
    for (int d = tid; d < 2048; d += 512) tbl[d] = rel_bias[rel_bucket(d) * 16 + col] * LOG2E;
}

template <bool HAS_BIAS, class Vis>
__device__ __forceinline__ void nv_attn_core(LAS float* Ks, LAS float* Vs, const LAS float* bias_d, const float (&q)[64], float (&o)[64], float& l_out,
                                             const bf16* Kg, int kpitch, const bf16* Vg, int vpitch, int t_lo, int t_hi, int qpos, int tid, Vis vis) {
    float m = -3.0e38f, l = 0.f;
#pragma unroll
    for (int d = 0; d < 64; ++d) o[d] = 0.f;
    const int srow = tid >> 3, sch = tid & 7;
    for (int t = t_lo; t < t_hi; ++t) {
        __syncthreads();
        { const v4u kw = *(const v4u*)(Kg + (size_t)(t * 64 + srow) * kpitch + sch * 8), vw = *(const v4u*)(Vg + (size_t)(t * 64 + srow) * vpitch + sch * 8);
          LAS f32x4* kd = (LAS f32x4*)(Ks + srow * 64 + sch * 8); LAS f32x4* vd = (LAS f32x4*)(Vs + srow * 64 + sch * 8);
          kd[0] = (f32x4){bf_lo(kw.x), bf_hi(kw.x), bf_lo(kw.y), bf_hi(kw.y)}; kd[1] = (f32x4){bf_lo(kw.z), bf_hi(kw.z), bf_lo(kw.w), bf_hi(kw.w)};
          vd[0] = (f32x4){bf_lo(vw.x), bf_hi(vw.x), bf_lo(vw.y), bf_hi(vw.y)}; vd[1] = (f32x4){bf_lo(vw.z), bf_hi(vw.z), bf_lo(vw.w), bf_hi(vw.w)}; }
        __syncthreads();
        for (int j = 0; j < 64; ++j) {
            const int kpos = t * 64 + j;
            if (vis(kpos)) {
                float s = 0.f;
#pragma unroll
                for (int d4 = 0; d4 < 16; ++d4) { const f32x4 kk = *(const LAS f32x4*)(Ks + j * 64 + d4 * 4); s += q[4 * d4] * kk[0] + q[4 * d4 + 1] * kk[1] + q[4 * d4 + 2] * kk[2] + q[4 * d4 + 3] * kk[3]; }
                if (HAS_BIAS) s += bias_d[qpos - kpos];
                if (s > m) { const float f = __builtin_amdgcn_exp2f(m - s); l *= f;
#pragma unroll
                    for (int d = 0; d < 64; ++d) o[d] *= f;
                    m = s; }
                const float p = __builtin_amdgcn_exp2f(s - m); l += p;
#pragma unroll
                for (int d4 = 0; d4 < 16; ++d4) { const f32x4 vv = *(const LAS f32x4*)(Vs + j * 64 + d4 * 4); o[4 * d4] += p * vv[0]; o[4 * d4 + 1] += p * vv[1]; o[4 * d4 + 2] += p * vv[2]; o[4 * d4 + 3] += p * vv[3]; }
            }
        }
    }
    l_out = l;
}
__device__ __forceinline__ void load_q64(float (&q)[64], const bf16* p) {
#pragma unroll
    for (int i = 0; i < 8; ++i) { const v4u w = *(const v4u*)(p + 8 * i);
        q[8 * i] = bf_lo(w.x); q[8 * i + 1] = bf_hi(w.x); q[8 * i + 2] = bf_lo(w.y); q[8 * i + 3] = bf_hi(w.y); q[8 * i + 4] = bf_lo(w.z); q[8 * i + 5] = bf_hi(w.z); q[8 * i + 6] = bf_lo(w.w); q[8 * i + 7] = bf_hi(w.w); }
}
__device__ __forceinline__ void store_bf64(bf16* p, const float (&o)[64], float sc) {
#pragma unroll
    for (int i = 0; i < 8; ++i) { v4u w; w.x = pk2(o[8 * i] * sc, o[8 * i + 1] * sc); w.y = pk2(o[8 * i + 2] * sc, o[8 * i + 3] * sc); w.z = pk2(o[8 * i + 4] * sc, o[8 * i + 5] * sc); w.w = pk2(o[8 * i + 6] * sc, o[8 * i + 7] * sc); *(v4u*)(p + 8 * i) = w; }
}

__device__ __forceinline__ float diff_lambda(const float* lq1, const float* lk1, const float* lq2, const float* lk2, float lambda_init) {
    float a = 0.f, b = 0.f;
    for (int i = 0; i < 64; ++i) { a += lq1[i] * lk1[i]; b += lq2[i] * lk2[i]; }
    return __expf(a) - __expf(b) + lambda_init;
}
__device__ __forceinline__ void ph_diff_attn_naive(const Ctx& c, const bf16* QKV, float* TMP, const float* rel_bias, float lam) {
    LAS float* Ks = (LAS float*)c.lds; LAS float* Vs = Ks + 4096; LAS float* tbl = Vs + 4096;
    for (int unit = c.bid; unit < NB * 8 * 4 * 2; unit += c.G) {
        const int vh = unit & 1, qb = 3 - ((unit >> 1) & 3), h = (unit >> 3) & 7, b = unit >> 6;
        const int qpos = qb * 512 + c.tid; const size_t t = (size_t)b * S + qpos;
        const bf16* base = QKV + (size_t)b * S * 3072;
        for (int m = 0; m < 2; ++m) {
            const int hm = 2 * h + m;
            __syncthreads();
            build_bias_tbl(tbl, rel_bias, hm, c.tid);
            float q[64], o[64], l; load_q64(q, QKV + t * 3072 + hm * 64);
            nv_attn_core<true>(Ks, Vs, tbl, q, o, l, base + 1024 + hm * 64, 3072, base + 2048 + h * 128 + vh * 64, 3072, 0, (qb + 1) * 8, qpos, c.tid, [=](int kpos) { return kpos <= qpos; });
            const float inv = 1.0f / l; float* dst = TMP + t * 1024 + h * 128 + vh * 64;
            if (m == 0) {
#pragma unroll
                for (int d4 = 0; d4 < 16; ++d4) *(f32x4*)(dst + 4 * d4) = (f32x4){o[4 * d4] * inv, o[4 * d4 + 1] * inv, o[4 * d4 + 2] * inv, o[4 * d4 + 3] * inv};
            } else {
                const float f = lam * inv;
#pragma unroll
                for (int d4 = 0; d4 < 16; ++d4) { f32x4 a = *(const f32x4*)(dst + 4 * d4); a = a - (f32x4){o[4 * d4] * f, o[4 * d4 + 1] * f, o[4 * d4 + 2] * f, o[4 * d4 + 3] * f}; *(f32x4*)(dst + 4 * d4) = a; }
            }
        }
    }
}
__device__ __forceinline__ void ph_diff_subln(const Ctx& c, const float* TMP, bf16* AO, const float* gain, float omli) {
    for (int m = c.gw; m < T; m += c.NGW) {
        const f32x4* r = (const f32x4*)(TMP + (size_t)m * 1024 + c.lane * 16);
        f32x4 v[4]; float s = 0.f;
#pragma unroll
        for (int j = 0; j < 4; ++j) { v[j] = r[j]; s += (v[j][0] * v[j][0] + v[j][1] * v[j][1]) + (v[j][2] * v[j][2] + v[j][3] * v[j][3]); }
        s += __shfl_xor(s, 1); s += __shfl_xor(s, 2); s += __shfl_xor(s, 4);
        const float rs = __builtin_amdgcn_rsqf(s * (1.0f / 128.0f) + 1e-6f) * omli;
        const f32x4* g = (const f32x4*)(gain + (c.lane & 7) * 16);
        v4u w0, w1; f32x4 a = v[0] * g[0] * rs, b = v[1] * g[1] * rs, cc = v[2] * g[2] * rs, dd = v[3] * g[3] * rs;
        w0.x = pk2(a[0], a[1]); w0.y = pk2(a[2], a[3]); w0.z = pk2(b[0], b[1]); w0.w = pk2(b[2], b[3]);
        w1.x = pk2(cc[0], cc[1]); w1.y = pk2(cc[2], cc[3]); w1.z = pk2(dd[0], dd[1]); w1.w = pk2(dd[2], dd[3]);
        v4u* o = (v4u*)(AO + (size_t)m * 1024 + c.lane * 16); o[0] = w0; o[1] = w1;
    }
}

__device__ __forceinline__ void ph_moba_kmean(const Ctx& c, const bf16* QKV, float* KM) {
    for (int it = c.gw; it < NB * 8 * 16; it += c.NGW) {
        const int h = it & 15, n = (it >> 4) & 7, b = it >> 7;
        const bf16* kp = QKV + ((size_t)b * S + n * 256 + (c.lane >> 3)) * 3072 + 1024 + h * 64 + (c.lane & 7) * 8;
        float a[8];
#pragma unroll
        for (int i = 0; i < 8; ++i) a[i] = 0.f;
#pragma unroll 2
        for (int j0 = 0; j0 < 32; j0 += 16) {
            v4u w[16];
#pragma unroll
            for (int j = 0; j < 16; ++j) w[j] = *(const v4u*)(kp + (size_t)(j0 + j) * 8 * 3072);
#pragma unroll
            for (int j = 0; j < 16; ++j) { a[0] += bf_lo(w[j].x); a[1] += bf_hi(w[j].x); a[2] += bf_lo(w[j].y); a[3] += bf_hi(w[j].y); a[4] += bf_lo(w[j].z); a[5] += bf_hi(w[j].z); a[6] += bf_lo(w[j].w); a[7] += bf_hi(w[j].w); }
        }
#pragma unroll
        for (int i = 0; i < 8; ++i) { a[i] += __shfl_xor(a[i], 8); a[i] += __shfl_xor(a[i], 16); a[i] += __shfl_xor(a[i], 32); }
        if (c.lane < 8) { float* dst = KM + ((size_t)(b * 16 + h) * 8 + n) * 64 + c.lane * 8;
            *(f32x4*)dst = (f32x4){a[0], a[1], a[2], a[3]} * (1.0f / 256.0f); *(f32x4*)(dst + 4) = (f32x4){a[4], a[5], a[6], a[7]} * (1.0f / 256.0f); }
    }
}
__device__ __forceinline__ void ph_moba_attn_naive(const Ctx& c, const bf16* QKV, const float* KM, bf16* AO, const float* rel_bias) {
    LAS float* Ks = (LAS float*)c.lds; LAS float* Vs = Ks + 4096; LAS float* tbl = Vs + 4096;
    for (int unit = c.bid; unit < NB * 16 * 4; unit += c.G) {
        const int qb = 3 - (unit & 3), h = (unit >> 2) & 15, b = unit >> 6;
        const int qpos = qb * 512 + c.tid; const size_t t = (size_t)b * S + qpos;
        const bf16* base = QKV + (size_t)b * S * 3072;
        __syncthreads();
        build_bias_tbl(tbl, rel_bias, h, c.tid);
        float q[64], o[64], l; load_q64(q, QKV + t * 3072 + h * 64);
        const int cur = qpos >> 8;
        float gt[8];
        const float* km = KM + (size_t)(b * 16 + h) * 8 * 64;
#pragma unroll
        for (int n = 0; n < 8; ++n) { float s = 0.f;
#pragma unroll
            for (int d = 0; d < 64; ++d) s += q[d] * km[n * 64 + d];
            gt[n] = (n < cur) ? s : -1.0e30f; }
        unsigned mask = 0u;
#pragma unroll
        for (int n = 0; n < 8; ++n) { int rank = 0;
#pragma unroll
            for (int n2 = 0; n2 < 8; ++n2) rank += (gt[n2] > gt[n] || (gt[n2] == gt[n] && n2 < n)) ? 1 : 0;
            if (rank < 3 && n < cur) mask |= 1u << n; }
        nv_attn_core<true>(Ks, Vs, tbl, q, o, l, base + 1024 + h * 64, 3072, base + 2048 + h * 64, 3072, 0, (qb + 1) * 8, qpos, c.tid,
                           [=](int kpos) { const int blk = kpos >> 8; return blk == cur ? kpos <= qpos : ((mask >> blk) & 1u) != 0u; });
        store_bf64(AO + t * 1024 + h * 64, o, 1.0f / l);
    }
}

__device__ __forceinline__ void ph_route_a(const Ctx& c, const bf16* H, const float* norm_ffn, const float* w_router, const float* b_router, int* ROUTE, float* RST, int* CNT, signed char* XQ) {
    LAS int* cnt = (LAS int*)c.lds;
    if (c.tid < 8) cnt[c.tid] = 0;
    __syncthreads();
    float wr[4][4][8];
#pragma unroll
    for (int j = 0; j < 4; ++j)
#pragma unroll
        for (int i = 0; i < 4; ++i) { const int k = 512 * (j >> 1) + 8 * c.lane + 4 * (j & 1) + i; const float g = norm_ffn[k]; const f32x4 a = *(const f32x4*)(w_router + k * 8), b2 = *(const f32x4*)(w_router + k * 8 + 4);
            wr[j][i][0] = g * a[0]; wr[j][i][1] = g * a[1]; wr[j][i][2] = g * a[2]; wr[j][i][3] = g * a[3]; wr[j][i][4] = g * b2[0]; wr[j][i][5] = g * b2[1]; wr[j][i][6] = g * b2[2]; wr[j][i][7] = g * b2[3]; }
    const int tpw = T / c.NGW;
    f32x4 vn[4];
    load_hrow(H + (size_t)(c.gw * tpw) * D, vn, c.lane);
    for (int k = 0; k < tpw; ++k) {
        const int m = c.gw * tpw + k;
        float lg[8]; float ss = 0.f, am = 0.f; f32x4 v[4];
#pragma unroll
        for (int e = 0; e < 8; ++e) lg[e] = 0.f;
#pragma unroll
        for (int j = 0; j < 4; ++j) v[j] = vn[j];
        if (k + 1 < tpw) load_hrow(H + (size_t)(m + 1) * D, vn, c.lane);
#pragma unroll
        for (int j = 0; j < 4; ++j) { ss += (v[j][0] * v[j][0] + v[j][1] * v[j][1]) + (v[j][2] * v[j][2] + v[j][3] * v[j][3]);
            am = __builtin_fmaxf(am, __builtin_fmaxf(__builtin_fmaxf(__builtin_fabsf(v[j][0]), __builtin_fabsf(v[j][1])), __builtin_fmaxf(__builtin_fabsf(v[j][2]), __builtin_fabsf(v[j][3]))));
#pragma unroll
            for (int i = 0; i < 4; ++i)
#pragma unroll
                for (int e = 0; e < 8; ++e) lg[e] += v[j][i] * wr[j][i][e]; }
        ss = wave_sum(ss); am = wave_max(am);
        const float rs = __builtin_amdgcn_rsqf(ss * (1.0f / 1024.0f) + 1e-6f);
        {
            float t4[4];
#pragma unroll
            for (int e = 0; e < 4; ++e) { const auto r = __builtin_amdgcn_permlane32_swap(__float_as_uint(lg[e]), __float_as_uint(lg[e + 4]), false, false); t4[e] = __uint_as_float(r[0]) + __uint_as_float(r[1]); }
            float u2[2];
#pragma unroll
            for (int e = 0; e < 2; ++e) { const auto r = __builtin_amdgcn_permlane16_swap(__float_as_uint(t4[e]), __float_as_uint(t4[e + 2]), false, false); u2[e] = __uint_as_float(r[0]) + __uint_as_float(r[1]); }
            const bool hi8 = (c.lane & 8) != 0;
            float vv = (hi8 ? u2[1] : u2[0]) + __shfl_xor(hi8 ? u2[0] : u2[1], 8);
            vv += __shfl_xor(vv, 4); vv += __shfl_xor(vv, 2); vv += __shfl_xor(vv, 1);
#pragma unroll
            for (int e = 0; e < 8; ++e) lg[e] = __uint_as_float((unsigned)__builtin_amdgcn_readlane((int)__float_as_uint(vv), 16 * (e >> 1) + 8 * (e & 1))) * rs + b_router[e];
        }
        int e1 = 0; float v1 = lg[0];
#pragma unroll
        for (int e = 1; e < 8; ++e) if (lg[e] > v1) { v1 = lg[e]; e1 = e; }
        int e2 = -1; float v2 = -3.0e38f;
#pragma unroll
        for (int e = 0; e < 8; ++e) if (e != e1 && lg[e] > v2) { v2 = lg[e]; e2 = e; }
        const float w2 = 1.0f / (1.0f + __expf(v1 - v2)), w1 = 1.0f - w2;
        quant_row(v, am, ss, XQ + (size_t)m * D, RST + m, c.lane);
        if (c.lane == 0) { int4 r; r.x = e1; r.y = e2; r.z = (int)__float_as_uint(w1); r.w = (int)__float_as_uint(w2); *(int4*)(ROUTE + (size_t)m * 4) = r;
            atomicAdd((int*)&cnt[e1], 1); atomicAdd((int*)&cnt[e2], 1); }
    }
    __syncthreads();
    if (c.tid < 8) CNT[c.bid * 8 + c.tid] = cnt[c.tid];
}
__device__ __forceinline__ void ph_route_b(const Ctx& c, const int* ROUTE, const float* RST, const int* CNT, int* SLOT, int* TOK, float* RSS, int* META, const signed char* XQ, signed char* XQS) {
    LAS int* sh = (LAS int*)c.lds;
    LAS int* cn = sh + 32; LAS int* rt = sh + 4096; LAS float* rsl = (LAS float*)(sh + 4096 + 256); LAS int* sl = sh + 4096 + 512;
    const int tpg = T / c.G;
    for (int i = c.tid; i < c.G * 8; i += 512) cn[i] = CNT[i];
    if (c.tid < tpg) { const int m = c.bid * tpg + c.tid; const int4 r = *(const int4*)(ROUTE + (size_t)m * 4); rt[2 * c.tid] = r.x; rt[2 * c.tid + 1] = r.y; rsl[c.tid] = RST[m]; }
    __syncthreads();
    if (c.tid < 8) { int tot = 0, pre = 0; for (int w = 0; w < c.G; ++w) { const int v = cn[w * 8 + c.tid]; tot += v; if (w < c.bid) pre += v; } sh[c.tid] = tot; sh[8 + c.tid] = pre; }
    __syncthreads();
    if (c.tid == 0) { int base = 0; for (int e = 0; e < 8; ++e) { sh[16 + e] = base; base += (sh[e] + 255) & ~255; } sh[24] = base; }
    __syncthreads();
    {
        LAS int* wc = sh + 4096 + 768;
        int e1 = -1, e2 = -1, r1 = 0, r2 = 0;
        if (c.tid < tpg) { e1 = rt[2 * c.tid]; e2 = rt[2 * c.tid + 1]; }
        if (c.tid < ((tpg + 63) & ~63)) {
#pragma unroll
            for (int e = 0; e < 8; ++e) { const unsigned long long bal = __ballot((e1 == e) || (e2 == e)); const int below = __popcll(bal & ((1ull << c.lane) - 1ull));
                if (e1 == e) r1 = below; if (e2 == e) r2 = below; if (c.lane == 0) wc[c.wave * 8 + e] = __popcll(bal); }
        }
        __syncthreads();
        if (c.tid < tpg) {
            const int m = c.bid * tpg + c.tid; const float rs = rsl[c.tid];
            for (int w = 0; w < c.wave; ++w) { r1 += wc[w * 8 + e1]; r2 += wc[w * 8 + e2]; }
            const int p1 = sh[16 + e1] + sh[8 + e1] + r1, p2 = sh[16 + e2] + sh[8 + e2] + r2;
            TOK[p1] = m; RSS[p1] = rs; SLOT[m * 2] = p1; sl[2 * c.tid] = p1;
            TOK[p2] = m; RSS[p2] = rs; SLOT[m * 2 + 1] = p2; sl[2 * c.tid + 1] = p2;
        }
    }
    if (c.bid == 0) {
        for (int e = 0; e < 8; ++e) { const int lo = sh[16 + e] + sh[e], hi = sh[17 + e];
            for (int p = lo + c.tid; p < hi; p += 512) { TOK[p] = 0; RSS[p] = 0.f; }
            for (int tl = (sh[16 + e] >> 8) + c.tid; tl < (hi >> 8); tl += 512) META[16 + tl] = e; }
        if (c.tid == 0) META[0] = sh[24] >> 8;
    }
    __syncthreads();
    for (int j0 = c.wave; j0 < 2 * tpg; j0 += 8 * NWAVES) {
        v4u v[8]; int pos[8];
#pragma unroll
        for (int u = 0; u < 8; ++u) { const int j = j0 + u * NWAVES; const int m = c.bid * tpg + (j >> 1); pos[u] = sl[j]; v[u] = *(const v4u*)(XQ + (size_t)m * D + c.lane * 16); }
#pragma unroll
        for (int u = 0; u < 8; ++u) *(v4u*)(XQS + (size_t)pos[u] * D + c.lane * 16) = v[u];
    }
}
template <bool LAST>
__device__ __forceinline__ void ph_moe_combine(const Ctx& c, bf16* H, const bf16* Y, const int* ROUTE, const int* SLOT, float* OUT, signed char* XQ, float* RA) {
    for (int m0 = c.gw * 4; m0 < T; m0 += c.NGW * 4) {
        int4 r[4]; int s1[4], s2[4];
#pragma unroll
        for (int u = 0; u < 4; ++u) { r[u] = *(const int4*)(ROUTE + (size_t)(m0 + u) * 4); s1[u] = SLOT[(m0 + u) * 2]; s2[u] = SLOT[(m0 + u) * 2 + 1]; }
        f32x4 v[4][4]; v4u a[4][2], b[4][2];
#pragma unroll
        for (int u = 0; u < 4; ++u) { load_hrow(H + (size_t)(m0 + u) * D, v[u], c.lane);
            const v4u* y1 = (const v4u*)(Y + (size_t)s1[u] * D) + c.lane; const v4u* y2 = (const v4u*)(Y + (size_t)s2[u] * D) + c.lane;
            a[u][0] = __builtin_nontemporal_load(y1); a[u][1] = __builtin_nontemporal_load(y1 + 64); b[u][0] = __builtin_nontemporal_load(y2); b[u][1] = __builtin_nontemporal_load(y2 + 64); }
#pragma unroll
        for (int u = 0; u < 4; ++u) { const float w1 = __uint_as_float((unsigned)r[u].z), w2 = __uint_as_float((unsigned)r[u].w);
#pragma unroll
            for (int hf = 0; hf < 2; ++hf) { f32x4 ya0, ya1, yb0, yb1; unpack8(a[u][hf], ya0, ya1); unpack8(b[u][hf], yb0, yb1);
                v[u][2 * hf] = v[u][2 * hf] + ya0 * w1 + yb0 * w2; v[u][2 * hf + 1] = v[u][2 * hf + 1] + ya1 * w1 + yb1 * w2; }
            if constexpr (LAST) store_frow(OUT + (size_t)(m0 + u) * D, v[u], c.lane);
            else {
                store_hrow(H + (size_t)(m0 + u) * D, v[u], c.lane);
                float ss = 0.f, am = 0.f;
#pragma unroll
                for (int j = 0; j < 4; ++j)
#pragma unroll
                    for (int i = 0; i < 4; ++i) { const float x = bf1((bf16)(pk2(v[u][j][i], 0.f) & 0xffffu)); v[u][j][i] = x; ss += x * x; am = __builtin_fmaxf(am, __builtin_fabsf(x)); }
                ss = wave_sum(ss); am = wave_max(am);
                quant_row(v[u], am, ss, XQ + (size_t)(m0 + u) * D, RA + m0 + u, c.lane); } }
    }
}
constexpr int NSA_LD = 2816;
__device__ __forceinline__ void ph_cmp_bias(const Ctx& c, const float* pos_k, const float* pos_v, const float* w1k, const float* w1v, float* CB) {
    for (int it = c.gw; it < 512; it += c.NGW) {
        const int br = it >> 8, j = it & 255; const float* pos = br ? pos_v : pos_k; const float* w1 = br ? w1v : w1k;
        float s = 0.f;
        for (int k = c.lane; k < 2048; k += 64) s += pos[k] * w1[(size_t)k * 256 + j];
        s = wave_sum(s);
        if (c.lane == 0) CB[it] = s;
    }
}
__device__ __forceinline__ void ph_cmp_stage2(const Ctx& c, const bf16* HID, const float* w2k, const float* w2v, const float* kgain0, bf16* KCMP, bf16* VCMP) {
    LAS float* w2l = (LAS float*)c.lds; LAS float* rowb = (LAS float*)(c.lds + 65536) + c.wave * 256;
    const int br = c.bid & 1; const float* w2 = br ? w2v : w2k;
    for (int i = c.tid; i < 256 * 64 / 4; i += 512) ((LAS f32x4*)w2l)[i] = ((const f32x4*)w2)[i];
    __syncthreads();
    const int nwb = (c.G >> 1) * NWAVES, wb = (c.bid >> 1) * NWAVES + c.wave;
    v2u hwn = *(const v2u*)(HID + ((size_t)br * 8192 + (wb < 8192 ? wb : 0)) * 256 + 4 * c.lane);
    for (int rho = wb; rho < 8192; rho += nwb) {
        const v2u hw = hwn;
        if (rho + nwb < 8192) hwn = *(const v2u*)(HID + ((size_t)br * 8192 + rho + nwb) * 256 + 4 * c.lane);
        asm volatile("" ::: "memory");
        *(LAS f32x4*)(rowb + 4 * c.lane) = (f32x4){bf_lo(hw.x), bf_hi(hw.x), bf_lo(hw.y), bf_hi(hw.y)};
        asm volatile("s_waitcnt lgkmcnt(0)" ::: "memory");
        float a = 0.f;
#pragma unroll 16
        for (int j = 0; j < 256; j += 4) { const f32x4 hv = *(const LAS f32x4*)(rowb + j);
            a += hv[0] * w2l[j * 64 + c.lane] + hv[1] * w2l[(j + 1) * 64 + c.lane] + hv[2] * w2l[(j + 2) * 64 + c.lane] + hv[3] * w2l[(j + 3) * 64 + c.lane]; }
        asm volatile("s_waitcnt lgkmcnt(0)" ::: "memory");
        if (br == 0) { const float ss = wave_sum(a * a); a *= __builtin_amdgcn_rsqf(ss * (1.0f / 64.0f) + 1e-6f) * kgain0[c.lane]; }
        const unsigned w = pk2(a, 0.f); (br ? VCMP : KCMP)[(size_t)rho * 64 + c.lane] = (bf16)(w & 0xffffu);
    }
}
__device__ __forceinline__ void ph_nsa_a_naive(const Ctx& c, const bf16* QKV, const bf16* KCMP, const bf16* VCMP, float* OC, unsigned* SEL) {
    LAS float* Kc = (LAS float*)c.lds; LAS float* Vc = Kc + 8192; LAS float* imp = Vc + 8192;
    for (int unit = c.bid; unit < NB * 4 * 4; unit += c.G) {
        const int qb = 3 - (unit & 3), g = (unit >> 2) & 3, b = unit >> 4;
        const int qpos = qb * 512 + c.tid; const size_t t = (size_t)b * S + qpos;
        __syncthreads();
        { const int row = c.tid >> 2, ch = (c.tid & 3) * 16; const size_t src = ((size_t)(b * 4 + g) * 128 + row) * 64 + ch;
#pragma unroll
          for (int i = 0; i < 2; ++i) { const v4u kw = *(const v4u*)(KCMP + src + 8 * i), vw = *(const v4u*)(VCMP + src + 8 * i);
              LAS f32x4* kd = (LAS f32x4*)(Kc + row * 64 + ch + 8 * i); LAS f32x4* vd = (LAS f32x4*)(Vc + row * 64 + ch + 8 * i);
              kd[0] = (f32x4){bf_lo(kw.x), bf_hi(kw.x), bf_lo(kw.y), bf_hi(kw.y)}; kd[1] = (f32x4){bf_lo(kw.z), bf_hi(kw.z), bf_lo(kw.w), bf_hi(kw.w)};
              vd[0] = (f32x4){bf_lo(vw.x), bf_hi(vw.x), bf_lo(vw.y), bf_hi(vw.y)}; vd[1] = (f32x4){bf_lo(vw.z), bf_hi(vw.z), bf_lo(vw.w), bf_hi(vw.w)}; } }
        for (int s = 0; s < 32; ++s) imp[s * 512 + c.tid] = 0.f;
        __syncthreads();
        const int nv = qpos >= 31 ? ((qpos - 31) >> 4) + 1 : 0;
        const int nvmax = (((qb * 512 + 511) - 31) >> 4) + 1;
        for (int r = 0; r < 4; ++r) {
            const int head = 4 * g + r;
            float q[64], o[64]; load_q64(q, QKV + t * NSA_LD + head * 64);
            float m = -3.0e38f, l = 0.f;
            for (int n = 0; n < nvmax; ++n) if (n < nv) {
                float s = 0.f;
#pragma unroll
                for (int d4 = 0; d4 < 16; ++d4) { const f32x4 kk = *(const LAS f32x4*)(Kc + n * 64 + d4 * 4); s += q[4 * d4] * kk[0] + q[4 * d4 + 1] * kk[1] + q[4 * d4 + 2] * kk[2] + q[4 * d4 + 3] * kk[3]; }
                if (s > m) { l *= __builtin_amdgcn_exp2f(m - s); m = s; }
                l += __builtin_amdgcn_exp2f(s - m);
            }
#pragma unroll
            for (int d = 0; d < 64; ++d) o[d] = 0.f;
            const float inv = l > 0.f ? 1.0f / l : 0.f;
            for (int n = 0; n < nvmax; ++n) if (n < nv) {
                float s = 0.f;
#pragma unroll
                for (int d4 = 0; d4 < 16; ++d4) { const f32x4 kk = *(const LAS f32x4*)(Kc + n * 64 + d4 * 4); s += q[4 * d4] * kk[0] + q[4 * d4 + 1] * kk[1] + q[4 * d4 + 2] * kk[2] + q[4 * d4 + 3] * kk[3]; }
                const float p = __builtin_amdgcn_exp2f(s - m) * inv;
#pragma unroll
                for (int d4 = 0; d4 < 16; ++d4) { const f32x4 vv = *(const LAS f32x4*)(Vc + n * 64 + d4 * 4); o[4 * d4] += p * vv[0]; o[4 * d4 + 1] += p * vv[1]; o[4 * d4 + 2] += p * vv[2]; o[4 * d4 + 3] += p * vv[3]; }
                const int sb = n >> 2;
                if ((n & 3) == 3) { imp[sb * 512 + c.tid] += p; imp[(sb + 1) * 512 + c.tid] += p; } else imp[sb * 512 + c.tid] += 2.0f * p;
            }
            float* dst = OC + t * 1024 + head * 64;
#pragma unroll
            for (int d4 = 0; d4 < 16; ++d4) *(f32x4*)(dst + 4 * d4) = (f32x4){o[4 * d4], o[4 * d4 + 1], o[4 * d4 + 2], o[4 * d4 + 3]};
        }
        const int cur = qpos >> 6; unsigned mask = 0u;
        for (int s = 0; s < 32; ++s) {
            const float vs = (s == 0 || s == cur || s == cur - 1) ? 1.0e30f : (s <= cur ? imp[s * 512 + c.tid] : -1.0e30f);
            int rank = 0;
            for (int s2 = 0; s2 < 32; ++s2) { const float v2 = (s2 == 0 || s2 == cur || s2 == cur - 1) ? 1.0e30f : (s2 <= cur ? imp[s2 * 512 + c.tid] : -1.0e30f);
                rank += (v2 > vs || (v2 == vs && s2 < s)) ? 1 : 0; }
            if (rank < 16) mask |= 1u << s;
        }
        SEL[t * 4 + g] = mask;
    }
}
__device__ __forceinline__ void ph_nsa_b_naive(const Ctx& c, const bf16* QKV, float* OC, const unsigned* SEL, bf16* AO, const float* rel_bias) {
    LAS float* Ks = (LAS float*)c.lds; LAS float* Vs = Ks + 4096; LAS float* tbl = Vs + 4096;
    for (int unit = c.bid; unit < NB * 16 * 4; unit += c.G) {
        const int qb = 3 - (unit & 3), head = (unit >> 2) & 15, b = unit >> 6, g = head >> 2;
        const int qpos = qb * 512 + c.tid; const size_t t = (size_t)b * S + qpos;
        const bf16* base = QKV + (size_t)b * S * NSA_LD;
        __syncthreads();
        build_bias_tbl(tbl, rel_bias, head, c.tid);
        float q[64], o[64], l; load_q64(q, QKV + t * NSA_LD + head * 64);
        const unsigned mask = SEL[t * 4 + g];
        const float g0 = bf1(QKV[t * NSA_LD + 2560 + head * 3]), g1 = bf1(QKV[t * NSA_LD + 2560 + head * 3 + 1]), g2 = bf1(QKV[t * NSA_LD + 2560 + head * 3 + 2]);
        float* oc = OC + t * 1024 + head * 64;
        nv_attn_core<true>(Ks, Vs, tbl, q, o, l, base + 1536 + g * 64, NSA_LD, base + 1792 + g * 64, NSA_LD, 0, (qb + 1) * 8, qpos, c.tid,
                           [=](int kpos) { return kpos <= qpos && ((mask >> (kpos >> 6)) & 1u) != 0u; });
        { const float f = g1 / l;
#pragma unroll
          for (int d4 = 0; d4 < 16; ++d4) { f32x4 a = *(const f32x4*)(oc + 4 * d4); a = a * g0 + (f32x4){o[4 * d4] * f, o[4 * d4 + 1] * f, o[4 * d4 + 2] * f, o[4 * d4 + 3] * f}; *(f32x4*)(oc + 4 * d4) = a; } }
        const int tlo = qb * 8 - 8 < 0 ? 0 : qb * 8 - 8;
        nv_attn_core<true>(Ks, Vs, tbl, q, o, l, base + 2048 + g * 64, NSA_LD, base + 2304 + g * 64, NSA_LD, tlo, (qb + 1) * 8, qpos, c.tid,
                           [=](int kpos) { return kpos <= qpos && qpos - kpos < 512; });
        { const float f = g2 / l; bf16* dst = AO + t * 1024 + head * 64;
#pragma unroll
          for (int i = 0; i < 8; ++i) { const f32x4 a0 = *(const f32x4*)(oc + 8 * i), a1 = *(const f32x4*)(oc + 8 * i + 4); v4u w;
              w.x = pk2(a0[0] + o[8 * i] * f, a0[1] + o[8 * i + 1] * f); w.y = pk2(a0[2] + o[8 * i + 2] * f, a0[3] + o[8 * i + 3] * f);
              w.z = pk2(a1[0] + o[8 * i + 4] * f, a1[1] + o[8 * i + 5] * f); w.w = pk2(a1[2] + o[8 * i + 6] * f, a1[3] + o[8 * i + 7] * f); *(v4u*)(dst + 8 * i) = w; } }
    }
}
namespace fa {
typedef short bf16x8 __attribute__((ext_vector_type(8)));
typedef short s16x4 __attribute__((ext_vector_type(4)));
typedef float f32x16 __attribute__((ext_vector_type(16)));
typedef unsigned u32x4 __attribute__((ext_vector_type(4)));
typedef short v4i16_t __attribute__((ext_vector_type(4)));
typedef LAS const char* lcp;
constexpr int DMAX = 2047, NTBL = 2144;
constexpr int TBL_BYTES = NTBL * 4;
constexpr float NEGBIG = -1.0e30f, MFLOOR = -1.0e29f;
constexpr int L_K = 0, L_V = 24576, L_WSF = 73728, L_OST = 75776, L_NEG = 108544, L_TBL = 108800;

__device__ __forceinline__ int crow0(int r) { return (r & 3) + 8 * (r >> 2); }
__device__ __forceinline__ int crow(int r, int hi) { return (r & 3) + 8 * (r >> 2) + 4 * hi; }
__device__ __forceinline__ unsigned cvtpk(float lo, float hi) { return pg8::cvt_pk_bf16(lo, hi); }
#define FA_MX3(a, b, c) __builtin_fmaxf(__builtin_fmaxf((a), (b)), (c))
__device__ __forceinline__ float rowmax32(const f32x16& p0, const f32x16& p1) {
    float a = FA_MX3(p0[0], p0[1], p1[0]), b = FA_MX3(p0[2], p0[3], p1[1]); a = FA_MX3(a, p1[2], p1[3]);
#pragma unroll
    for (int r = 4; r < 16; r += 4) { a = FA_MX3(a, p0[r], p0[r + 1]); b = FA_MX3(b, p0[r + 2], p0[r + 3]); a = FA_MX3(a, p1[r], p1[r + 1]); b = FA_MX3(b, p1[r + 2], p1[r + 3]); }
    float rm = __builtin_fmaxf(a, b);
    auto rr = __builtin_amdgcn_permlane32_swap(__float_as_uint(rm), __float_as_uint(rm), false, false);
    return __builtin_fmaxf(__uint_as_float(rr[0]), __uint_as_float(rr[1]));
}
__device__ __forceinline__ float swap_add(float v) { auto rr = __builtin_amdgcn_permlane32_swap(__float_as_uint(v), __float_as_uint(v), false, false); return __uint_as_float(rr[0]) + __uint_as_float(rr[1]); }
__device__ __forceinline__ s16x4 vtr(lcp p) { return __builtin_bit_cast(s16x4, __builtin_amdgcn_ds_read_tr16_b64_v4i16((LAS v4i16_t*)p)); }

__device__ __forceinline__ void build_tbl(LAS float* tbl, const float* rel_bias, int col, int wlimit, int tid) {
    for (int j = tid; j < NTBL; j += 512) { const int d = DMAX - j; tbl[j] = (d < 0 || d >= wlimit) ? NEGBIG : rel_bias[rel_bucket(d) * 16 + col] * LOG2E; }
}
__device__ __forceinline__ void build_neg(LAS float* neg, int tid) { if (tid < 64) neg[tid] = NEGBIG; }

__device__ __forceinline__ void row_bcast(float (&fr)[16], float f, LAS float* wsf, int r32, int hi);
template <int NV> struct State { f32x16 o[NV]; float m, l; };
template <int NV> __device__ __forceinline__ void st_init(State<NV>& st) {
#pragma unroll
    for (int i = 0; i < NV; ++i) st.o[i] = f32x16{};
    st.m = MFLOOR; st.l = 0.f;
}
struct Stream { const bf16* Kg; const bf16* Vg; int kpitch, vpitch; };

__device__ __forceinline__ unsigned range_mask(int lo, int hi) { const unsigned a = hi >= 32 ? 0xffffffffu : ((1u << hi) - 1u); const unsigned b = lo <= 0 ? 0u : ((1u << lo) - 1u); return a & ~b; }
struct NoFix { __device__ __forceinline__ void operator()(int, f32x16&, f32x16&) const {} };
struct Ring { int c, n, f; };
template <int NV, class TP, class ACT, class FIX>
__device__ __forceinline__ void run_tiles(State<NV>& st, const bf16x8 (&qr)[4], const Stream& sm, unsigned tmask, LAS char* ring, LAS float* wsf, TP tptr, ACT active, FIX fix, int wid, int lane, Ring& rg, bool primed = false) {
    const int r32 = lane & 31, hi = lane >> 5;
    constexpr int VSLOT = NV * 4096;
    const bf16* ksrc = sm.Kg + (size_t)lane * sm.kpitch + wid * 8;
    const bf16* vsrc = sm.Vg + (size_t)(16 * (wid & 3) + (lane >> 2)) * sm.vpitch + (wid >> 2) * 32 + (lane & 3) * 8;
    LAS char* kdst = ring + L_K + wid * 1024; LAS char* vdst = ring + L_V + wid * 1024;
    const lcp kp0 = ring + L_K + hi * 1024 + r32 * 16;
    const lcp vp0 = ring + L_V + ((lane >> 4) & 1) * 32 + (lane & 3) * 8 + (4 * hi + ((lane & 15) >> 2)) * 64;
#define FA_DMA(t, slot) do { \
        __builtin_amdgcn_global_load_lds((const unsigned*)(ksrc + (size_t)(t) * 64 * sm.kpitch), (LAS unsigned*)(kdst + (slot) * 8192), 16, 0, 0); \
        __builtin_amdgcn_global_load_lds((const unsigned*)(vsrc + (size_t)(t) * 64 * sm.vpitch), (LAS unsigned*)(vdst + (slot) * VSLOT), 16, 0, 0); \
        if (NV == 4) __builtin_amdgcn_global_load_lds((const unsigned*)(vsrc + (size_t)(t) * 64 * sm.vpitch + 64), (LAS unsigned*)(vdst + (slot) * VSLOT + 8192), 16, 0, 0); } while (0)
    unsigned rem = (unsigned)__builtin_amdgcn_readfirstlane((int)tmask);
    if (rem == 0u) return;
    int s_cur = rg.c, s_nxt = rg.n, s_fre = rg.f;
    int tA = __builtin_ctz(rem), tB = -1; rem &= rem - 1u;
    if (!primed) FA_DMA(tA, s_cur);
    if (rem) { tB = __builtin_ctz(rem); rem &= rem - 1u; if (!primed) FA_DMA(tB, s_nxt); }
    while (tA >= 0) {
        const int t = tA;
        if (tB >= 0) { if (NV == 4) asm volatile("s_waitcnt vmcnt(3)\n\ts_barrier" ::: "memory"); else asm volatile("s_waitcnt vmcnt(2)\n\ts_barrier" ::: "memory"); }
        else asm volatile("s_waitcnt vmcnt(0)\n\ts_barrier" ::: "memory");
        int tC = -1;
        if (rem) { tC = __builtin_ctz(rem); rem &= rem - 1u; FA_DMA(tC, s_fre); }
        if (active(t)) {
            const LAS float* tp = tptr(t);
            f32x16 p0, p1;
#pragma unroll
            for (int r = 0; r < 16; ++r) { p0[r] = tp[crow0(r)]; p1[r] = tp[crow0(r) + 32]; }
            fix(t, p0, p1);
            const lcp kp = kp0 + s_cur * 8192;
            bf16x8 kf[8];
#pragma unroll
            for (int d0 = 0; d0 < 4; ++d0) { kf[2 * d0] = *(const LAS bf16x8*)(kp + d0 * 2048); kf[2 * d0 + 1] = *(const LAS bf16x8*)(kp + d0 * 2048 + 512); }
#pragma unroll
            for (int d0 = 0; d0 < 4; ++d0) {
                p0 = __builtin_amdgcn_mfma_f32_32x32x16_bf16(kf[2 * d0], qr[d0], p0, 0, 0, 0); p1 = __builtin_amdgcn_mfma_f32_32x32x16_bf16(kf[2 * d0 + 1], qr[d0], p1, 0, 0, 0);
            }
            const lcp vp = vp0 + s_cur * VSLOT;
            s16x4 vlo[8], vhh[8];
#pragma unroll
            for (int j = 0; j < 8; ++j) { vlo[j] = vtr(vp + (j >> 2) * 4096 + (j & 3) * 1024); vhh[j] = vtr(vp + (j >> 2) * 4096 + (j & 3) * 1024 + 512); }
            const float rm = rowmax32(p0, p1);
            if (__any(rm > st.m + 8.0f)) {
                const float mn = __builtin_fmaxf(st.m, rm), f = __builtin_amdgcn_exp2f(st.m - mn);
                st.l *= f; st.m = mn;
                float fr_[16]; row_bcast(fr_, f, wsf, r32, hi);
#pragma unroll
                for (int i = 0; i < NV; ++i)
#pragma unroll
                    for (int r = 0; r < 16; ++r) st.o[i][r] *= fr_[r];
            }
            const float mm = st.m; float sacc = 0.f;
#pragma unroll
            for (int r = 0; r < 16; ++r) { p0[r] = __builtin_amdgcn_exp2f(p0[r] - mm); p1[r] = __builtin_amdgcn_exp2f(p1[r] - mm); sacc += p0[r] + p1[r]; }
            st.l += sacc;
            u32x4 pw0, pw1, pw2, pw3;
            pw0 = (u32x4){cvtpk(p0[0], p0[1]), cvtpk(p0[2], p0[3]), cvtpk(p0[4], p0[5]), cvtpk(p0[6], p0[7])};
            pw1 = (u32x4){cvtpk(p0[8], p0[9]), cvtpk(p0[10], p0[11]), cvtpk(p0[12], p0[13]), cvtpk(p0[14], p0[15])};
            pw2 = (u32x4){cvtpk(p1[0], p1[1]), cvtpk(p1[2], p1[3]), cvtpk(p1[4], p1[5]), cvtpk(p1[6], p1[7])};
            pw3 = (u32x4){cvtpk(p1[8], p1[9]), cvtpk(p1[10], p1[11]), cvtpk(p1[12], p1[13]), cvtpk(p1[14], p1[15])};
#define FA_PKV(j) (bf16x8){vlo[j][0], vlo[j][1], vlo[j][2], vlo[j][3], vhh[j][0], vhh[j][1], vhh[j][2], vhh[j][3]}
#pragma unroll
            for (int i = 0; i < 2; ++i) {
                st.o[i] = __builtin_amdgcn_mfma_f32_32x32x16_bf16(__builtin_bit_cast(bf16x8, pw0), FA_PKV(4 * i + 0), st.o[i], 0, 0, 0);
                st.o[i] = __builtin_amdgcn_mfma_f32_32x32x16_bf16(__builtin_bit_cast(bf16x8, pw1), FA_PKV(4 * i + 1), st.o[i], 0, 0, 0);
                st.o[i] = __builtin_amdgcn_mfma_f32_32x32x16_bf16(__builtin_bit_cast(bf16x8, pw2), FA_PKV(4 * i + 2), st.o[i], 0, 0, 0);
                st.o[i] = __builtin_amdgcn_mfma_f32_32x32x16_bf16(__builtin_bit_cast(bf16x8, pw3), FA_PKV(4 * i + 3), st.o[i], 0, 0, 0);
            }
            if (NV == 4) {
#pragma unroll
                for (int j = 0; j < 8; ++j) { vlo[j] = vtr(vp + 8192 + (j >> 2) * 4096 + (j & 3) * 1024); vhh[j] = vtr(vp + 8192 + (j >> 2) * 4096 + (j & 3) * 1024 + 512); }
#pragma unroll
                for (int i = 0; i < 2; ++i) {
                    st.o[2 + i] = __builtin_amdgcn_mfma_f32_32x32x16_bf16(__builtin_bit_cast(bf16x8, pw0), FA_PKV(4 * i + 0), st.o[2 + i], 0, 0, 0);
                    st.o[2 + i] = __builtin_amdgcn_mfma_f32_32x32x16_bf16(__builtin_bit_cast(bf16x8, pw1), FA_PKV(4 * i + 1), st.o[2 + i], 0, 0, 0);
                    st.o[2 + i] = __builtin_amdgcn_mfma_f32_32x32x16_bf16(__builtin_bit_cast(bf16x8, pw2), FA_PKV(4 * i + 2), st.o[2 + i], 0, 0, 0);
                    st.o[2 + i] = __builtin_amdgcn_mfma_f32_32x32x16_bf16(__builtin_bit_cast(bf16x8, pw3), FA_PKV(4 * i + 3), st.o[2 + i], 0, 0, 0);
                }
            }
#undef FA_PKV
        }
        tA = tB; tB = tC;
        { const int tmp = s_cur; s_cur = s_nxt; s_nxt = s_fre; s_fre = tmp; }
    }
    rg.c = s_cur; rg.n = s_nxt; rg.f = s_fre;
#undef FA_DMA
}
template <int NV>
__device__ __forceinline__ void prefetch2(const Stream& sm, unsigned tmask, LAS char* ring, const Ring& rg, int wid, int lane) {
    constexpr int VSLOT = NV * 4096;
    const bf16* ksrc = sm.Kg + (size_t)lane * sm.kpitch + wid * 8;
    const bf16* vsrc = sm.Vg + (size_t)(16 * (wid & 3) + (lane >> 2)) * sm.vpitch + (wid >> 2) * 32 + (lane & 3) * 8;
    LAS char* kdst = ring + L_K + wid * 1024; LAS char* vdst = ring + L_V + wid * 1024;
    unsigned rem = (unsigned)__builtin_amdgcn_readfirstlane((int)tmask);
#pragma unroll
    for (int k = 0; k < 2; ++k) {
        if (rem == 0u) break;
        const int t = __builtin_ctz(rem); rem &= rem - 1u; const int slot = k ? rg.n : rg.c;
        __builtin_amdgcn_global_load_lds((const unsigned*)(ksrc + (size_t)t * 64 * sm.kpitch), (LAS unsigned*)(kdst + slot * 8192), 16, 0, 0);
        __builtin_amdgcn_global_load_lds((const unsigned*)(vsrc + (size_t)t * 64 * sm.vpitch), (LAS unsigned*)(vdst + slot * VSLOT), 16, 0, 0);
        if (NV == 4) __builtin_amdgcn_global_load_lds((const unsigned*)(vsrc + (size_t)t * 64 * sm.vpitch + 64), (LAS unsigned*)(vdst + slot * VSLOT + 8192), 16, 0, 0);
    }
}
template <class TP, class ACT>
__device__ __forceinline__ void run_tiles2(State<2>& sA, State<2>& sB, const bf16x8 (&qa)[4], const bf16x8 (&qb_)[4], const Stream& sm, unsigned tmask, LAS char* ring, LAS float* wsf, TP tptr, ACT active, int wid, int lane) {
    const int r32 = lane & 31, hi = lane >> 5;
    constexpr int VSLOT = 8192;
    const bf16* ksrc = sm.Kg + (size_t)lane * sm.kpitch + wid * 8;
    const bf16* vsrc = sm.Vg + (size_t)(16 * (wid & 3) + (lane >> 2)) * sm.vpitch + (wid >> 2) * 32 + (lane & 3) * 8;
    LAS char* kdst = ring + L_K + wid * 1024; LAS char* vdst = ring + L_V + wid * 1024;
    const lcp kp0 = ring + L_K + hi * 1024 + r32 * 16;
    const lcp vp0 = ring + L_V + ((lane >> 4) & 1) * 32 + (lane & 3) * 8 + (4 * hi + ((lane & 15) >> 2)) * 64;
#define FA_DMA(t, slot) do { \
        __builtin_amdgcn_global_load_lds((const unsigned*)(ksrc + (size_t)(t) * 64 * sm.kpitch), (LAS unsigned*)(kdst + (slot) * 8192), 16, 0, 0); \
        __builtin_amdgcn_global_load_lds((const unsigned*)(vsrc + (size_t)(t) * 64 * sm.vpitch), (LAS unsigned*)(vdst + (slot) * VSLOT), 16, 0, 0); } while (0)
    unsigned rem = (unsigned)__builtin_amdgcn_readfirstlane((int)tmask);
    if (rem == 0u) return;
    int s_cur = 0, s_nxt = 1, s_fre = 2;
    int tA = __builtin_ctz(rem), tB = -1; rem &= rem - 1u;
    FA_DMA(tA, 0);
    if (rem) { tB = __builtin_ctz(rem); rem &= rem - 1u; FA_DMA(tB, 1); }
    while (tA >= 0) {
        const int t = tA;
        if (tB >= 0) asm volatile("s_waitcnt vmcnt(2)\n\ts_barrier" ::: "memory"); else asm volatile("s_waitcnt vmcnt(0)\n\ts_barrier" ::: "memory");
        int tC = -1;
        if (rem) { tC = __builtin_ctz(rem); rem &= rem - 1u; FA_DMA(tC, s_fre); }
        const bool a0 = active(t, 0), a1 = active(t, 1);
        if (a0 || a1) {
            const lcp kp = kp0 + s_cur * 8192; const lcp vp = vp0 + s_cur * VSLOT;
#define FA_SUB(ST, QR, SB) do { \
            const LAS float* tp = tptr(t, SB); \
            f32x16 p0, p1; \
            _Pragma("unroll") for (int r = 0; r < 16; ++r) { p0[r] = tp[crow0(r)]; p1[r] = tp[crow0(r) + 32]; } \
            bf16x8 kf[8]; \
            _Pragma("unroll") for (int d0 = 0; d0 < 4; ++d0) { kf[2 * d0] = *(const LAS bf16x8*)(kp + d0 * 2048); kf[2 * d0 + 1] = *(const LAS bf16x8*)(kp + d0 * 2048 + 512); } \
            _Pragma("unroll") for (int d0 = 0; d0 < 4; ++d0) { p0 = __builtin_amdgcn_mfma_f32_32x32x16_bf16(kf[2 * d0], QR[d0], p0, 0, 0, 0); p1 = __builtin_amdgcn_mfma_f32_32x32x16_bf16(kf[2 * d0 + 1], QR[d0], p1, 0, 0, 0); } \
            const float rm = rowmax32(p0, p1); \
            if (__any(rm > ST.m + 8.0f)) { const float mn = __builtin_fmaxf(ST.m, rm), f = __builtin_amdgcn_exp2f(ST.m - mn); ST.l *= f; ST.m = mn; float fr_[16]; row_bcast(fr_, f, wsf, r32, hi); \
                _Pragma("unroll") for (int r = 0; r < 16; ++r) { ST.o[0][r] *= fr_[r]; ST.o[1][r] *= fr_[r]; } } \
            const float mm = ST.m; float sacc = 0.f; \
            _Pragma("unroll") for (int r = 0; r < 16; ++r) { p0[r] = __builtin_amdgcn_exp2f(p0[r] - mm); p1[r] = __builtin_amdgcn_exp2f(p1[r] - mm); sacc += p0[r] + p1[r]; } \
            ST.l += sacc; \
            s16x4 vlo[8], vhh[8]; \
            _Pragma("unroll") for (int j = 0; j < 8; ++j) { vlo[j] = vtr(vp + (j >> 2) * 4096 + (j & 3) * 1024); vhh[j] = vtr(vp + (j >> 2) * 4096 + (j & 3) * 1024 + 512); } \
            const u32x4 pw0 = (u32x4){cvtpk(p0[0], p0[1]), cvtpk(p0[2], p0[3]), cvtpk(p0[4], p0[5]), cvtpk(p0[6], p0[7])}, pw1 = (u32x4){cvtpk(p0[8], p0[9]), cvtpk(p0[10], p0[11]), cvtpk(p0[12], p0[13]), cvtpk(p0[14], p0[15])}; \
            const u32x4 pw2 = (u32x4){cvtpk(p1[0], p1[1]), cvtpk(p1[2], p1[3]), cvtpk(p1[4], p1[5]), cvtpk(p1[6], p1[7])}, pw3 = (u32x4){cvtpk(p1[8], p1[9]), cvtpk(p1[10], p1[11]), cvtpk(p1[12], p1[13]), cvtpk(p1[14], p1[15])}; \
            _Pragma("unroll") for (int i = 0; i < 2; ++i) { \
                ST.o[i] = __builtin_amdgcn_mfma_f32_32x32x16_bf16(__builtin_bit_cast(bf16x8, pw0), FA_PKV2(4 * i + 0), ST.o[i], 0, 0, 0); \
                ST.o[i] = __builtin_amdgcn_mfma_f32_32x32x16_bf16(__builtin_bit_cast(bf16x8, pw1), FA_PKV2(4 * i + 1), ST.o[i], 0, 0, 0); \
                ST.o[i] = __builtin_amdgcn_mfma_f32_32x32x16_bf16(__builtin_bit_cast(bf16x8, pw2), FA_PKV2(4 * i + 2), ST.o[i], 0, 0, 0); \
                ST.o[i] = __builtin_amdgcn_mfma_f32_32x32x16_bf16(__builtin_bit_cast(bf16x8, pw3), FA_PKV2(4 * i + 3), ST.o[i], 0, 0, 0); } } while (0)
#define FA_PKV2(j) (bf16x8){vlo[j][0], vlo[j][1], vlo[j][2], vlo[j][3], vhh[j][0], vhh[j][1], vhh[j][2], vhh[j][3]}
            if (a0) FA_SUB(sA, qa, 0);
            if (a1) FA_SUB(sB, qb_, 1);
#undef FA_SUB
#undef FA_PKV2
        }
        tA = tB; tB = tC;
        { const int tmp = s_cur; s_cur = s_nxt; s_nxt = s_fre; s_fre = tmp; }
    }
#undef FA_DMA
}
__device__ __forceinline__ void row_bcast(float (&fr)[16], float f, LAS float* wsf, int r32, int hi) {
    asm volatile("" ::: "memory");
    if (hi == 0) wsf[r32] = f;
    asm volatile("s_waitcnt lgkmcnt(0)" ::: "memory");
#pragma unroll
    for (int r = 0; r < 16; ++r) fr[r] = wsf[crow(r, hi)];
    asm volatile("" ::: "memory");
}
__device__ __forceinline__ void store_o64(const f32x16& oa, const f32x16& ob, bf16* dst, int ldo, LAS char* ost, int lane) {
    const int r32 = lane & 31, hi = lane >> 5;
    LAS bf16* stg = (LAS bf16*)ost;
#pragma unroll
    for (int r = 0; r < 16; ++r) { const int orow = crow(r, hi); stg[orow * 64 + r32] = (bf16)(cvtpk(oa[r], 0.f) & 0xffffu); stg[orow * 64 + 32 + r32] = (bf16)(cvtpk(ob[r], 0.f) & 0xffffu); }
    asm volatile("s_waitcnt lgkmcnt(0)" ::: "memory");
#pragma unroll
    for (int i = 0; i < 4; ++i) { const int row = i * 8 + (lane >> 3), ch = lane & 7; const u32x4 v = *(const LAS u32x4*)(stg + row * 64 + ch * 8); *(u32x4*)(dst + (size_t)row * ldo + ch * 8) = v; }
    asm volatile("s_waitcnt lgkmcnt(0)" ::: "memory");
}
}

__device__ __forceinline__ void ph_moba_attn(const Ctx& c, const bf16* QKV, bf16* AO, const float* rel_bias) {
    LAS char* ring = (LAS char*)c.lds;
    LAS float* wsf = (LAS float*)(ring + fa::L_WSF) + c.wave * 64;
    LAS float* neg = (LAS float*)(ring + fa::L_NEG); LAS float* tbl = (LAS float*)(ring + fa::L_TBL);
    LAS float* kml = (LAS float*)(ring + fa::L_TBL + fa::TBL_BYTES);
    const int lane = c.lane, wid = c.wave, r32 = lane & 31, hi = lane >> 5;
    for (int bh = c.bid; bh < NB * 16; bh += c.G) {
        const int b = bh >> 4, h = bh & 15;
        __syncthreads();
        fa::build_tbl(tbl, rel_bias, h, 1 << 30, c.tid); fa::build_neg(neg, c.tid);
        const bf16* base = QKV + (size_t)b * S * 3072;
        {
            const bf16* kp = base + (size_t)(wid * 256 + (lane >> 3)) * 3072 + 1024 + h * 64 + (lane & 7) * 8;
            float a[8];
#pragma unroll
            for (int i = 0; i < 8; ++i) a[i] = 0.f;
#pragma unroll 2
            for (int j0 = 0; j0 < 32; j0 += 16) {
                v4u w[16];
#pragma unroll
                for (int j = 0; j < 16; ++j) w[j] = *(const v4u*)(kp + (size_t)(j0 + j) * 8 * 3072);
#pragma unroll
                for (int j = 0; j < 16; ++j) { a[0] += bf_lo(w[j].x); a[1] += bf_hi(w[j].x); a[2] += bf_lo(w[j].y); a[3] += bf_hi(w[j].y); a[4] += bf_lo(w[j].z); a[5] += bf_hi(w[j].z); a[6] += bf_lo(w[j].w); a[7] += bf_hi(w[j].w); }
            }
#pragma unroll
            for (int i = 0; i < 8; ++i) { a[i] += __shfl_xor(a[i], 8); a[i] += __shfl_xor(a[i], 16); a[i] += __shfl_xor(a[i], 32); }
            if (lane < 8) {
#pragma unroll
                for (int i = 0; i < 8; ++i) kml[wid * 64 + lane * 8 + i] = a[i] * (1.0f / 256.0f); }
        }
        __syncthreads();
        const fa::Stream sm{base + 1024 + h * 64, base + 2048 + h * 64, 3072, 3072};
        for (int qi = 0; qi < 4; ++qi) {
            const int Q = 3 - qi;
            const int qw0 = Q * 512 + wid * 64, cur = qw0 >> 8;
            fa::bf16x8 qa[4], qb_[4]; unsigned maskA = 0u, maskB = 0u;
#pragma unroll
            for (int sb = 0; sb < 2; ++sb) {
                const int qpos = qw0 + 32 * sb + r32;
                fa::bf16x8 qr[4];
#pragma unroll
                for (int d0 = 0; d0 < 4; ++d0) qr[d0] = *(const fa::bf16x8*)(base + (size_t)qpos * 3072 + h * 64 + d0 * 16 + hi * 8);
                float gt[8]; unsigned mask = 0u;
#pragma unroll
                for (int n = 0; n < 8; ++n) { float s = 0.f;
#pragma unroll
                    for (int d0 = 0; d0 < 4; ++d0)
#pragma unroll
                        for (int j = 0; j < 8; ++j) s += bf1((bf16)qr[d0][j]) * kml[n * 64 + d0 * 16 + hi * 8 + j];
                    s = fa::swap_add(s); gt[n] = (n < cur) ? s : -1.0e30f; }
#pragma unroll
                for (int n = 0; n < 8; ++n) { int rank = 0;
#pragma unroll
                    for (int n2 = 0; n2 < 8; ++n2) rank += (gt[n2] > gt[n] || (gt[n2] == gt[n] && n2 < n)) ? 1 : 0;
                    if (rank < 3 && n < cur) mask |= 1u << n; }
                mask |= 1u << cur;
                if (sb == 0) { maskA = mask;
#pragma unroll
                    for (int d0 = 0; d0 < 4; ++d0) qa[d0] = qr[d0]; }
                else { maskB = mask;
#pragma unroll
                    for (int d0 = 0; d0 < 4; ++d0) qb_[d0] = qr[d0]; }
            }
            fa::State<2> sA, sB; fa::st_init(sA); fa::st_init(sB);
            const LAS float* trowA = tbl + (fa::DMAX - (qw0 + r32) + 4 * hi); const LAS float* trowB = trowA - 32;
            asm volatile("s_barrier" ::: "memory");
            fa::run_tiles2(sA, sB, qa, qb_, sm, fa::range_mask(0, 8 * (Q + 1)), ring, wsf,
                [=](int t, int sb) -> const LAS float* { const unsigned mk = sb ? maskB : maskA; return ((mk >> (t >> 2)) & 1u) ? (sb ? trowB : trowA) + 64 * t : (const LAS float*)neg; },
                [=](int t, int sb) -> bool { const unsigned mk = sb ? maskB : maskA; return 64 * t <= qw0 + 32 * sb + 31 && __any((int)((mk >> (t >> 2)) & 1u)); }, wid, lane);
#pragma unroll
            for (int sb = 0; sb < 2; ++sb) {
                fa::State<2>& st = sb ? sB : sA;
                const float lt = fa::swap_add(st.l); float fr[16]; fa::row_bcast(fr, 1.0f / lt, wsf, r32, hi);
#pragma unroll
                for (int r = 0; r < 16; ++r) { st.o[0][r] *= fr[r]; st.o[1][r] *= fr[r]; }
                fa::store_o64(st.o[0], st.o[1], AO + ((size_t)b * S + qw0 + 32 * sb) * 1024 + h * 64, 1024, ring + fa::L_OST + wid * 4096, lane);
            }
        }
    }
}
__device__ __forceinline__ void diff_pass(fa::State<4>& st, const bf16* base, int hm, int h, int qb, int qw, int qpos, const LAS float* tbl, LAS char* ring, LAS float* wsf, int wid, int lane, fa::Ring& rg, bool primed) {
    const int hi = lane >> 5;
    fa::bf16x8 qr[4];
#pragma unroll
    for (int d0 = 0; d0 < 4; ++d0) qr[d0] = *(const fa::bf16x8*)(base + (size_t)qpos * 3072 + hm * 64 + d0 * 16 + hi * 8);
    fa::st_init(st);
    const LAS float* trow = tbl + (fa::DMAX - qpos + 4 * hi);
    const fa::Stream sm{base + 1024 + hm * 64, base + 2048 + h * 128, 3072, 3072};
    if (!primed) asm volatile("s_barrier" ::: "memory");
    fa::run_tiles<4>(st, qr, sm, fa::range_mask(0, 4 * (qb + 1)), ring, wsf,
        [=](int t) -> const LAS float* { return trow + 64 * t; },
        [=](int t) -> bool { return 64 * t <= qw + 31; }, fa::NoFix(), wid, lane, rg, primed);
}
__device__ __forceinline__ void ph_diff_attn(const Ctx& c, const bf16* QKV, signed char* AO8, float* SCR, const float* rel_bias, float lam, const float* subln_gain, float omli) {
    LAS char* ring = (LAS char*)c.lds;
    LAS float* wsf = (LAS float*)(ring + fa::L_WSF) + c.wave * 64;
    LAS float* tbl0 = (LAS float*)(ring + fa::L_TBL); LAS float* tbl1 = (LAS float*)(ring + fa::L_TBL + fa::TBL_BYTES);
    const int lane = c.lane, wid = c.wave, r32 = lane & 31, hi = lane >> 5;
    float* scr = SCR + (size_t)c.gw * 4096 + lane * 64;
    for (int ui = c.bid; ui < NB * 8 * 2; ui += c.G) {
        const int par = (ui >> 3) & 1, bh = (ui & 7) * 16 + (ui >> 4), b = bh >> 3, h = bh & 7;
        __syncthreads();
        fa::build_tbl(tbl0, rel_bias, 2 * h, 1 << 30, c.tid); fa::build_tbl(tbl1, rel_bias, 2 * h + 1, 1 << 30, c.tid);
        __syncthreads();
        const bf16* base = QKV + (size_t)b * S * 3072;
        fa::Ring rg{0, 1, 2};
        for (int qi = 0; qi < 4; ++qi) {
            const int qb = par ? (qi == 0 ? 7 : qi == 1 ? 4 : qi == 2 ? 3 : 0) : (qi == 0 ? 6 : qi == 1 ? 5 : qi == 2 ? 2 : 1);
            const int qbn = par ? (qi == 0 ? 4 : qi == 1 ? 3 : 0) : (qi == 0 ? 5 : qi == 1 ? 2 : 1);
            const int qw = qb * 256 + wid * 32, qpos = qw + r32;
            unsigned pk[16];
            LAS unsigned* park = (LAS unsigned*)(ring + fa::L_OST + wid * 4096) + lane;
            {
                fa::State<4> st; diff_pass(st, base, 2 * h, h, qb, qw, qpos, tbl0, ring, wsf, wid, lane, rg, qi > 0);
                fa::prefetch2<4>(fa::Stream{base + 1024 + (2 * h + 1) * 64, base + 2048 + h * 128, 3072, 3072}, fa::range_mask(0, 4 * (qb + 1)), ring, rg, wid, lane);
                const float lt = fa::swap_add(st.l); float fr[16]; fa::row_bcast(fr, 1.0f / lt, wsf, r32, hi);
#pragma unroll
                for (int i = 0; i < 2; ++i)
#pragma unroll
                    for (int r2 = 0; r2 < 8; ++r2) park[(i * 8 + r2) * 64] = fa::cvtpk(st.o[i][2 * r2] * fr[2 * r2], st.o[i][2 * r2 + 1] * fr[2 * r2 + 1]);
#pragma unroll
                for (int i = 2; i < 4; ++i)
#pragma unroll
                    for (int r2 = 0; r2 < 8; ++r2) pk[(i - 2) * 8 + r2] = fa::cvtpk(st.o[i][2 * r2] * fr[2 * r2], st.o[i][2 * r2 + 1] * fr[2 * r2 + 1]);
                asm volatile("s_waitcnt lgkmcnt(0)" ::: "memory");
            }
            {
                fa::State<4> st; diff_pass(st, base, 2 * h + 1, h, qb, qw, qpos, tbl1, ring, wsf, wid, lane, rg, true);
                if (qi < 3) fa::prefetch2<4>(fa::Stream{base + 1024 + 2 * h * 64, base + 2048 + h * 128, 3072, 3072}, fa::range_mask(0, 4 * (qbn + 1)), ring, rg, wid, lane);
                const float lt = fa::swap_add(st.l); float fr[16]; fa::row_bcast(fr, lam / lt, wsf, r32, hi);
#pragma unroll
                for (int i = 0; i < 4; ++i)
#pragma unroll
                    for (int r2 = 0; r2 < 8; ++r2) { const unsigned w = i < 2 ? park[(i * 8 + r2) * 64] : pk[(i - 2) * 8 + r2];
                        st.o[i][2 * r2] = bf_lo(w) - st.o[i][2 * r2] * fr[2 * r2]; st.o[i][2 * r2 + 1] = bf_hi(w) - st.o[i][2 * r2 + 1] * fr[2 * r2 + 1]; }
                asm volatile("s_waitcnt lgkmcnt(0)" ::: "memory");
                float g4[4];
#pragma unroll
                for (int i = 0; i < 4; ++i) g4[i] = subln_gain[32 * i + r32] * omli;
#pragma unroll
                for (int r = 0; r < 16; ++r) {
                    float ss = st.o[0][r] * st.o[0][r] + st.o[1][r] * st.o[1][r] + st.o[2][r] * st.o[2][r] + st.o[3][r] * st.o[3][r];
                    ss += __shfl_xor(ss, 1); ss += __shfl_xor(ss, 2); ss += __shfl_xor(ss, 4); ss += __shfl_xor(ss, 8); ss += __shfl_xor(ss, 16);
                    const float rs = __builtin_amdgcn_rsqf(ss * (1.0f / 128.0f) + 1e-6f);
#pragma unroll
                    for (int i = 0; i < 4; ++i) st.o[i][r] *= rs * g4[i];
                }
                {
                    const float qs = 127.0f / (6.0f * omli);
                    LAS unsigned char* stg = (LAS unsigned char*)(ring + fa::L_OST + wid * 4096);
#pragma unroll
                    for (int i = 0; i < 4; ++i)
#pragma unroll
                        for (int r = 0; r < 16; ++r) { float v = __builtin_amdgcn_fmed3f(st.o[i][r] * qs, -127.0f, 127.0f); stg[fa::crow(r, hi) * 128 + 32 * i + r32] = (unsigned char)(int)__builtin_rintf(v); }
                    asm volatile("s_waitcnt lgkmcnt(0)" ::: "memory");
                    signed char* dst = AO8 + ((size_t)b * S + qw) * 1024 + h * 128;
                    const int row = lane >> 1, hf = lane & 1;
#pragma unroll
                    for (int k = 0; k < 4; ++k) { const fa::u32x4 v = *(const LAS fa::u32x4*)(stg + row * 128 + hf * 64 + k * 16); *(fa::u32x4*)(dst + (size_t)row * 1024 + hf * 64 + k * 16) = v; }
                    asm volatile("s_waitcnt lgkmcnt(0)" ::: "memory");
                }
            }
        }
    }
}

#ifndef EXP_SEL
#define EXP_SEL 1.0f
#define EXP_WIN 1.0f
#define EXP_CMP 1.0f
#endif
__device__ __forceinline__ void ph_nsa_b(const Ctx& c, const bf16* QKV, const bf16* KCMP, const bf16* VCMP, const unsigned* SEL, bf16* AO, const float* rel_bias) {
    LAS char* ring = (LAS char*)c.lds;
    LAS float* wsf = (LAS float*)(ring + fa::L_WSF) + c.wave * 64;
    LAS float* neg = (LAS float*)(ring + fa::L_NEG);
    LAS unsigned* um = (LAS unsigned*)(ring + fa::L_WSF) + 40;
    LAS float* tblc = (LAS float*)(ring + fa::L_TBL + 2 * fa::TBL_BYTES);
    const int lane = c.lane, wid = c.wave, r32 = lane & 31, hi = lane >> 5, hr = wid >> 1, qh = wid & 1;
    LAS float* tblh = (LAS float*)(ring + (hr < 2 ? 49152 + hr * fa::TBL_BYTES : fa::L_TBL + (hr - 2) * fa::TBL_BYTES));
    for (int ui = c.bid; ui < NB * 4 * 4; ui += c.G) {
        const int sset = (ui >> 3) & 3, bg = (ui & 7) * 8 + (ui >> 5), b = bg >> 2, g = bg & 3, head = 4 * g + hr;
        __syncthreads();
        for (int i = 0; i < 4; ++i) fa::build_tbl((LAS float*)(ring + (i < 2 ? 49152 + i * fa::TBL_BYTES : fa::L_TBL + (i - 2) * fa::TBL_BYTES)), rel_bias, 4 * g + i, 1 << 30, c.tid);
        fa::build_neg(neg, c.tid);
        if (c.tid < 256) tblc[c.tid] = c.tid < 128 ? 0.f : fa::NEGBIG;
        __syncthreads();
        const bf16* base = QKV + (size_t)b * S * NSA_LD;
        const fa::Stream ssel{base + 1536 + g * 64, base + 1792 + g * 64, NSA_LD, NSA_LD}, swin{base + 2048 + g * 64, base + 2304 + g * 64, NSA_LD, NSA_LD};
        const fa::Stream scmp{KCMP + (size_t)bg * 128 * 64, VCMP + (size_t)bg * 128 * 64, 64, 64};
        fa::bf16x8 qn[4]; unsigned selmn; bf16 gn0, gn1, gn2;
#define NB_LOAD(ck_) do { const int qp_ = 64 * (ck_) + 32 * qh + r32; \
            selmn = __hip_atomic_load(SEL + ((size_t)b * S + qp_) * 4 + g, __ATOMIC_RELAXED, __HIP_MEMORY_SCOPE_AGENT);     \
            _Pragma("unroll") for (int d0 = 0; d0 < 4; ++d0) qn[d0] = *(const fa::bf16x8*)(base + (size_t)qp_ * NSA_LD + head * 64 + d0 * 16 + hi * 8); \
            gn0 = base[(size_t)qp_ * NSA_LD + 2560 + head * 3]; gn1 = base[(size_t)qp_ * NSA_LD + 2560 + head * 3 + 1]; gn2 = base[(size_t)qp_ * NSA_LD + 2560 + head * 3 + 2]; } while (0)
        NB_LOAD(3 * 8 + (7 - sset));
        fa::Ring rg{0, 1, 2};
        for (int ci = 0; ci < 8; ++ci) {
            const int k8 = 7 - ci, ck = (k8 >> 1) * 8 + ((k8 & 1) ? 7 - sset : sset);
            const int qw = 64 * ck + 32 * qh, qpos = qw + r32;
            const unsigned selm = selmn;
            fa::bf16x8 qr[4];
#pragma unroll
            for (int d0 = 0; d0 < 4; ++d0) qr[d0] = qn[d0];
            const float g0 = bf1(gn0), g1 = bf1(gn1), g2 = bf1(gn2);
            if (ci < 7) { const int k8n = 6 - ci; NB_LOAD((k8n >> 1) * 8 + ((k8n & 1) ? 7 - sset : sset)); }
            if (c.tid == 0) *um = 0u;
            asm volatile("s_waitcnt lgkmcnt(0)\n\ts_barrier" ::: "memory");
            atomicOr((unsigned*)um, selm);
            asm volatile("s_waitcnt lgkmcnt(0)\n\ts_barrier" ::: "memory");
            const unsigned U = *um & fa::range_mask(0, ck + 1);
            const LAS float* trow = tblh + (fa::DMAX - qpos + 4 * hi);
            fa::f32x16 acc0, acc1;
            const int nmax = qpos >= 31 ? ((qpos - 31) >> 4) : -1;
            const LAS float* tpc = tblc + (127 - nmax) + 4 * hi;
#pragma unroll
            for (int r = 0; r < 16; ++r) { acc0[r] = 0.f; acc1[r] = 0.f; }
#pragma unroll 1
            for (int ps = 0; ps < 2; ++ps) {
                fa::State<2> st; fa::st_init(st);
                const fa::Stream sm = ps ? ssel : scmp;
                const unsigned tm = ps ? U : ((4 * ck + 2) >= 64 ? 3u : 1u);
                const unsigned onm = ps ? selm : 0xffffffffu;
                const LAS float* bp = ps ? trow : tpc;
                const float gg = ps ? g1 : g0;
                fa::run_tiles<2>(st, qr, sm, tm, ring, wsf,
                    [=](int tt) -> const LAS float* { return ((onm >> tt) & 1u) ? bp + 64 * tt : (const LAS float*)neg; },
                    [=](int tt) -> bool { return __any((int)((onm >> tt) & 1u)) != 0; }, fa::NoFix(), wid, lane, rg);
                const float lt = fa::swap_add(st.l); float fr[16]; fa::row_bcast(fr, lt > 0.f ? gg / lt : 0.f, wsf, r32, hi);
#pragma unroll
                for (int r = 0; r < 16; ++r) { acc0[r] += st.o[0][r] * fr[r]; acc1[r] += st.o[1][r] * fr[r]; }
            }
            {
                fa::State<2> st; fa::st_init(st);
                const int told = ck - 8, qi = 32 * qh + r32;
                fa::run_tiles<2>(st, qr, swin, fa::range_mask(told < 0 ? 0 : told, ck + 1), ring, wsf,
                    [=](int tt) -> const LAS float* { return trow + 64 * tt; },
                    [=](int) -> bool { return true; },
                    [=](int tt, fa::f32x16& p0, fa::f32x16& p1) { if (tt == told) {
#pragma unroll
                        for (int r = 0; r < 16; ++r) { const int kj = fa::crow(r, hi); if (kj <= qi) p0[r] = fa::NEGBIG; if (kj + 32 <= qi) p1[r] = fa::NEGBIG; } } }, wid, lane, rg);
                const float lt = fa::swap_add(st.l); float fr[16]; fa::row_bcast(fr, g2 / lt, wsf, r32, hi);
#pragma unroll
                for (int r = 0; r < 16; ++r) { acc0[r] += st.o[0][r] * fr[r] * EXP_WIN; acc1[r] += st.o[1][r] * fr[r] * EXP_WIN; }
            }
            fa::store_o64(acc0, acc1, AO + ((size_t)b * S + qw) * 1024 + head * 64, 1024, ring + fa::L_OST + wid * 4096, lane);
        }
    }
#undef NB_LOAD
}

__device__ __forceinline__ void ph_nsa_a(const Ctx& c, const bf16* QKV, const bf16* KCMP, const bf16* VCMP, unsigned* SEL) {
    LAS char* ring = (LAS char*)c.lds;
    LAS float* wsf = (LAS float*)(ring + fa::L_WSF) + c.wave * 64;
    LAS float* tblc = (LAS float*)(ring + 58368);
    LAS float* imph = (LAS float*)(ring + fa::L_OST);
    LAS float* tot = (LAS float*)(ring + 49152);
    LAS unsigned* selw = (LAS unsigned*)(ring + 57856);
    const int lane = c.lane, wid = c.wave, r32 = lane & 31, hi = lane >> 5, hr = wid >> 1, qh = wid & 1;
    for (int ui = c.bid; ui < NB * 4 * 4; ui += c.G) {
        const int sset = (ui >> 3) & 3, bg = (ui & 7) * 8 + (ui >> 5), b = bg >> 2, g = bg & 3, head = 4 * g + hr;
        __syncthreads();
        if (c.tid < 256) tblc[c.tid] = c.tid < 128 ? 0.f : fa::NEGBIG;
        {
            const bf16* kc = KCMP + (size_t)bg * 128 * 64; const bf16* vc = VCMP + (size_t)bg * 128 * 64;
            const bf16* ksrc = kc + (size_t)lane * 64 + wid * 8;
            const bf16* vsrc = vc + (size_t)(16 * (wid & 3) + (lane >> 2)) * 64 + (wid >> 2) * 32 + (lane & 3) * 8;
#pragma unroll
            for (int t = 0; t < 2; ++t) {
                __builtin_amdgcn_global_load_lds((const unsigned*)(ksrc + t * 64 * 64), (LAS unsigned*)(ring + fa::L_K + wid * 1024 + t * 8192), 16, 0, 0);
                __builtin_amdgcn_global_load_lds((const unsigned*)(vsrc + t * 64 * 64), (LAS unsigned*)(ring + fa::L_V + wid * 1024 + t * 8192), 16, 0, 0);
            }
            asm volatile("s_waitcnt vmcnt(0)" ::: "memory");
        }
        __syncthreads();
        const bf16* base = QKV + (size_t)b * S * NSA_LD;
        const fa::lcp kp0 = ring + fa::L_K + hi * 1024 + r32 * 16;
        const fa::lcp vp0 = ring + fa::L_V + ((lane >> 4) & 1) * 32 + (lane & 3) * 8 + (4 * hi + ((lane & 15) >> 2)) * 64;
        fa::bf16x8 qn[4];
        { const int ck0 = 3 * 8 + (7 - sset), qp0 = 64 * ck0 + 32 * qh + r32;
#pragma unroll
          for (int d0 = 0; d0 < 4; ++d0) qn[d0] = *(const fa::bf16x8*)(base + (size_t)qp0 * NSA_LD + head * 64 + d0 * 16 + hi * 8); }
        for (int ci = 0; ci < 8; ++ci) {
            const int k8 = 7 - ci, ck = (k8 >> 1) * 8 + ((k8 & 1) ? 7 - sset : sset);
            const int qw = 64 * ck + 32 * qh, qpos = qw + r32; const size_t tq = (size_t)b * S + qpos;
            fa::bf16x8 qr[4];
#pragma unroll
            for (int d0 = 0; d0 < 4; ++d0) qr[d0] = qn[d0];
            if (ci < 7) { const int k8n = 6 - ci, ckn = (k8n >> 1) * 8 + ((k8n & 1) ? 7 - sset : sset), qpn = 64 * ckn + 32 * qh + r32;
#pragma unroll
                for (int d0 = 0; d0 < 4; ++d0) qn[d0] = *(const fa::bf16x8*)(base + (size_t)qpn * NSA_LD + head * 64 + d0 * 16 + hi * 8); }
            const int nmax = qpos >= 31 ? ((qpos - 31) >> 4) : -1;
            const bool two = (4 * ck + 2) >= 64;
            const LAS float* tp = tblc + (127 - nmax) + 4 * hi;
            fa::f32x16 s0, s1, s2, s3;
#pragma unroll
            for (int r = 0; r < 16; ++r) { s0[r] = tp[fa::crow0(r)]; s1[r] = tp[fa::crow0(r) + 32]; s2[r] = fa::NEGBIG; s3[r] = fa::NEGBIG; }
#pragma unroll
            for (int d0 = 0; d0 < 4; ++d0) {
                const fa::bf16x8 b0 = *(const LAS fa::bf16x8*)(kp0 + d0 * 2048), b1 = *(const LAS fa::bf16x8*)(kp0 + d0 * 2048 + 512);
                s0 = __builtin_amdgcn_mfma_f32_32x32x16_bf16(b0, qr[d0], s0, 0, 0, 0); s1 = __builtin_amdgcn_mfma_f32_32x32x16_bf16(b1, qr[d0], s1, 0, 0, 0);
            }
            if (two) {
#pragma unroll
                for (int r = 0; r < 16; ++r) { s2[r] = tp[fa::crow0(r) + 64]; s3[r] = tp[fa::crow0(r) + 96]; }
#pragma unroll
                for (int d0 = 0; d0 < 4; ++d0) {
                    const fa::bf16x8 b0 = *(const LAS fa::bf16x8*)(kp0 + 8192 + d0 * 2048), b1 = *(const LAS fa::bf16x8*)(kp0 + 8192 + d0 * 2048 + 512);
                    s2 = __builtin_amdgcn_mfma_f32_32x32x16_bf16(b0, qr[d0], s2, 0, 0, 0); s3 = __builtin_amdgcn_mfma_f32_32x32x16_bf16(b1, qr[d0], s3, 0, 0, 0);
                }
            }
            float m = __builtin_fmaxf(fa::rowmax32(s0, s1), fa::rowmax32(s2, s3));
            m = __builtin_fmaxf(m, fa::MFLOOR);
            float l = 0.f;
#pragma unroll
            for (int r = 0; r < 16; ++r) { s0[r] = __builtin_amdgcn_exp2f(s0[r] - m); s1[r] = __builtin_amdgcn_exp2f(s1[r] - m); s2[r] = __builtin_amdgcn_exp2f(s2[r] - m); s3[r] = __builtin_amdgcn_exp2f(s3[r] - m); l += (s0[r] + s1[r]) + (s2[r] + s3[r]); }
            l = fa::swap_add(l);
            const float inv = l > 0.f ? 1.0f / l : 0.f;
#pragma unroll
            for (int r = 0; r < 16; ++r) { s0[r] *= inv; s1[r] *= inv; s2[r] *= inv; s3[r] *= inv; }
            float av[16], sp[16];
#define NA_GRP(P, idx, k) do { av[idx] = 2.0f * (P[4 * (k)] + P[4 * (k) + 1] + P[4 * (k) + 2]) + P[4 * (k) + 3]; sp[idx] = P[4 * (k) + 3]; } while (0)
            NA_GRP(s0, 0, 0); NA_GRP(s0, 1, 1); NA_GRP(s0, 2, 2); NA_GRP(s0, 3, 3); NA_GRP(s1, 4, 0); NA_GRP(s1, 5, 1); NA_GRP(s1, 6, 2); NA_GRP(s1, 7, 3);
            NA_GRP(s2, 8, 0); NA_GRP(s2, 9, 1); NA_GRP(s2, 10, 2); NA_GRP(s2, 11, 3); NA_GRP(s3, 12, 0); NA_GRP(s3, 13, 1); NA_GRP(s3, 14, 2); NA_GRP(s3, 15, 3);
#undef NA_GRP
            asm volatile("s_barrier" ::: "memory");
            {
                LAS float* row = imph + (hr * 64 + 32 * qh + r32) * 33;
#pragma unroll
                for (int idx = 0; idx < 16; ++idx) {
                    auto rr = __builtin_amdgcn_permlane32_swap(__float_as_uint(sp[idx]), __float_as_uint(sp[idx]), false, false);
                    const float other = __uint_as_float(hi ? rr[0] : rr[1]);
                    sp[idx] = other;
                }
#pragma unroll
                for (int idx = 0; idx < 16; ++idx) {
                    const float add = hi ? sp[idx] : (idx > 0 ? sp[idx - 1] : 0.f);
                    row[2 * idx + hi] = av[idx] + add;
                }
            }
            if (c.tid < 64) selw[c.tid] = 0u;
            asm volatile("s_waitcnt lgkmcnt(0)\n\ts_barrier" ::: "memory");
            {
                const int q = c.tid & 63, sb = c.tid >> 6;
#pragma unroll
                for (int j = 0; j < 4; ++j) { const int s = sb + 8 * j; tot[q * 33 + s] = ((imph[(0 * 64 + q) * 33 + s] + imph[(1 * 64 + q) * 33 + s]) + imph[(2 * 64 + q) * 33 + s]) + imph[(3 * 64 + q) * 33 + s]; }
                asm volatile("s_waitcnt lgkmcnt(0)\n\ts_barrier" ::: "memory");
                float vs[4]; int rank[4];
#pragma unroll
                for (int j = 0; j < 4; ++j) { const int s = sb + 8 * j; vs[j] = (s == 0 || s == ck || s == ck - 1) ? 1.0e30f : (s <= ck ? tot[q * 33 + s] : -1.0e30f); rank[j] = 0; }
                for (int s2 = 0; s2 < 32; ++s2) {
                    const float v2 = (s2 == 0 || s2 == ck || s2 == ck - 1) ? 1.0e30f : (s2 <= ck ? tot[q * 33 + s2] : -1.0e30f);
#pragma unroll
                    for (int j = 0; j < 4; ++j) { const int s = sb + 8 * j; rank[j] += (v2 > vs[j] || (v2 == vs[j] && s2 < s)) ? 1 : 0; }
                }
                unsigned bits = 0u;
#pragma unroll
                for (int j = 0; j < 4; ++j) if (rank[j] < 16) bits |= 1u << (sb + 8 * j);
                atomicOr((unsigned*)&selw[q], bits);
                asm volatile("s_waitcnt lgkmcnt(0)\n\ts_barrier" ::: "memory");
                if (c.tid < 64) SEL[((size_t)b * S + 64 * ck + c.tid) * 4 + g] = selw[c.tid];
            }
            (void)tq;
        }
    }
}
#ifndef MK_PER_PHASE
#define MK_PER_PHASE 0
#endif
constexpr int NPH = 34;
struct Args { const float* in[NIN]; float* out; unsigned char* ws; int ph_lo, ph_hi; };

__device__ __forceinline__ int opaque_i(int k) { int r; asm volatile("s_mov_b32 %0, %1" : "=s"(r) : "s"(k)); return r; }

__global__ void __launch_bounds__(NWAVES * 64, 2) mk_fwd(Args args) {
    extern __shared__ __attribute__((aligned(16))) unsigned char lds_raw[];
    Ctx c;
    c.lds = (LAS unsigned char*)lds_raw;
    c.tid = threadIdx.x; c.lane = c.tid & 63; c.wave = __builtin_amdgcn_readfirstlane(c.tid >> 6);
    c.bid = blockIdx.x; c.G = gridDim.x; c.gw = c.bid * NWAVES + c.wave; c.NGW = c.G * NWAVES;
    volatile LAS unsigned* MISC = (volatile LAS unsigned*)(c.lds + MISC_OFF);
    for (int u = c.tid; u < (LDS_BYTES - RING_BYTES) / 4; u += NWAVES * 64) ((LAS unsigned*)(c.lds + RING_BYTES))[u] = 0u;
    __syncthreads();
    gu32* ctl = (gu32*)(args.ws + WS_CTL);
    XcdBarrier bar = xcd_barrier_post((unsigned*)(ctl + CW_BAR), MISC + 8);
    const int lo = args.ph_lo, hi = args.ph_hi;
#ifndef PH_MASK
#define PH_MASK 0xFFFFFFFFFFFFull
#endif
#ifndef PH_DUP_MASK
#define PH_DUP_MASK 0ull
#endif
#define PH_BEGIN(k) if (((PH_MASK >> (k)) & 1ull) && lo <= (k) && (k) < hi) { for (int rep_ = 0; rep_ < (((PH_DUP_MASK >> (k)) & 1ull) ? 2 : 1); ++rep_) { if (rep_) xcd_barrier(bar); GAS unsigned char* gws_ = (GAS unsigned char*)args.ws; GAS float* gout_ = (GAS float*)args.out; asm volatile("" : "+s"(gws_), "+s"(gout_)); unsigned char* lws = (unsigned char*)gws_; float* lout = (float*)gout_;
#define PH_END(k) } if ((k) + 1 < hi) xcd_barrier(bar); }
#define IN(k) ((const float*)(const GAS float*)args.in[opaque_i(k)])
#define H ((bf16*)(lws + WS_XB))
#define OUTF ((float*)lout)
#define SSQ ((float*)(lws + WS_SSQ))
#define XB ((bf16*)(lws + WS_XB))
#define WIN ((bf16*)(lws + WS_WIN))
#define WOUT ((bf16*)(lws + WS_WOUT))
#define CW1 ((bf16*)(lws + WS_CW1))
#define WFF ((bf16*)(lws + WS_WFF))
#define QKV ((bf16*)(lws + WS_QKV))
#define AO ((bf16*)(lws + WS_AO))
#define TMP ((float*)(lws + WS_TMP))
#define HB ((bf16*)(lws + WS_HB))
#define YB ((bf16*)(lws + WS_Y))
#define ROUTE ((int*)(lws + WS_ROUTE))
#define SLOT ((int*)(lws + WS_SLOT))
#define TOK ((int*)(lws + WS_TOK))
#define RSS ((float*)(lws + WS_RSS))
#define CNT ((int*)(lws + WS_CNT))
#define META ((int*)(lws + WS_META))
#define RST ((float*)(lws + WS_RST))
#define KM ((float*)(lws + WS_KM))
#define SEL ((unsigned*)(lws + WS_SEL))
#define CB ((float*)(lws + WS_CB))
#define KCMP ((bf16*)(lws + WS_KCMP))
#define VCMP ((bf16*)(lws + WS_VCMP))
#define HID ((bf16*)(lws + WS_HID))
#define REL_BIAS IN(1)
#define XQ ((signed char*)(lws + WS_XQ))
#define SWS ((float*)(lws + WS_SW))
#define CMAXP(off) ((int*)(lws + WS_CTL + (off)))
#define WFF8 ((unsigned char*)(lws + WS_WFF))
#define SWD ((float*)(lws + WS_SWD))
#define HSC ((float*)(lws + WS_HSC))
#define HQ ((signed char*)(lws + WS_HB))
#define XQS ((signed char*)(lws + WS_XQS))
#define SWI ((float*)(lws + WS_SWI))
#define SWO ((float*)(lws + WS_SWO))
#define AO8 ((signed char*)(lws + WS_AO))
#define WOUT8 ((signed char*)(lws + WS_WOUT))
#define WIN8 ((signed char*)(lws + WS_WIN))

#define SCLA (RST + T)
#define SCLB (RST + 2 * T)
#define ACCP(k_) ((unsigned long long*)(lws + WS_SSQ) + (size_t)(k_) * T)
#define GEMM_QKV(KIND, NCOLS, qg_, kg_, PRED_, ak_) do { pg8::Gemm g{XQ, WIN8, 8, 1024u, 128u}; pg8::PlainSched Sd; Sd.init(T, NCOLS, 1024u, 1024u, c.G, c.bid); \
        epi::EpiQKV8<KIND, PRED_> E{QKV, NCOLS, PRED_ ? SCLA : RST, SWI, qg_, kg_, C2, ACCP(ak_), c.lds + RING_BYTES + 1024}; pg8::gemm_phase<epi::EpiQKV8<KIND, PRED_>, pg8::PlainSched, true, true>(c.lds, g, Sd, E); } while (0)
#define CVQ_WIN(w_in_, ncols_, npad_, nm_, cm_, pass_) cvq_matrix(c, w_in_, 1024, ncols_, npad_, ncols_, nm_, WIN8, CMAXP(cm_), SWI, 1, pass_, rot, true)
#define GEMM_WOUT(PRED_, ak_) do { pg8::Gemm g{AO, WOUT, 16, 2048u, 128u}; pg8::PlainSched Sd; Sd.init(T, 1024, 2048u, 2048u, c.G, c.bid); \
        epi::EpiResidLean<PRED_> E{H, {XQ, ACCP(ak_), SCLA, SCLB}}; pg8::gemm_phase<epi::EpiResidLean<PRED_>, pg8::PlainSched, true>(c.lds, g, Sd, E); } while (0)
#define GEMM_WOUT8(omli_, PRED_, ak_) do { pg8::Gemm g{AO8, WOUT8, 8, 1024u, 128u}; pg8::PlainSched Sd; Sd.init(T, 1024, 1024u, 1024u, c.G, c.bid); \
        epi::EpiResidLean8<PRED_> E{H, SWO, 6.0f * (omli_) * (1.0f / 127.0f), {XQ, ACCP(ak_), SCLA, SCLB}, c.lds + RING_BYTES + 1024}; pg8::gemm_phase<epi::EpiResidLean8<PRED_>, pg8::PlainSched, true, true>(c.lds, g, Sd, E); } while (0)
#define CVQ_WOUT(w_out_, cm_, pass_) cvq_matrix(c, w_out_, 1024, 1024, 1024, 1024, nullptr, WOUT8, CMAXP(cm_), SWO, 0, pass_, rot, true)
#define GEMM_FFN_UP(ak_) do { pg8::Gemm g{XQ, WFF8, 8, 1024u, 128u}; pg8::PlainSched Sd; Sd.init(T, 7168, 1024u, 1024u, c.G, c.bid); \
        epi::EpiSwiGLU8<true> E{HQ, FF, SCLB, SWS, HSC, ACCP(ak_), c.lds + RING_BYTES + 1024}; pg8::gemm_phase<epi::EpiSwiGLU8<true>, pg8::PlainSched, true, true>(c.lds, g, Sd, E); } while (0)
#define GEMM_FFN_DOWN(ak_) do { pg8::Gemm g{HQ, WFF8 + (size_t)7168 * 1024, 28, 3584u, 128u}; pg8::PlainSched Sd; Sd.init(T, 1024, 3584u, 3584u, c.G, c.bid); \
        epi::EpiResid8<true> E{H, SWD, HSC, {XQ, ACCP(ak_), SCLB, SCLA}, c.lds + RING_BYTES + 1024}; pg8::gemm_phase<epi::EpiResid8<true>, pg8::PlainSched, true, true>(c.lds, g, Sd, E); } while (0)
#define MOE_TILE_TABLE() LAS int* te_ = (LAS int*)(c.lds + RING_BYTES + 1024 + 10240); for (int i_ = c.tid; i_ < ntile; i_ += NWAVES * 64) te_[i_] = META[16 + i_]; __syncthreads()
#define GEMM_MOE_UP() do { const int ntile = META[0]; MOE_TILE_TABLE(); pg8::Gemm g{XQS, WFF8, 8, 1024u, 128u}; pg8::MoeSched Sd; Sd.init(ntile, 7168, 1024u, 1024u, (size_t)7168 * 1024, c.G, c.bid, te_, nullptr); \
        epi::EpiSwiGLU8<false> E{HQ, FF, RSS, SWS, HSC, nullptr, c.lds + RING_BYTES + 1024}; pg8::gemm_phase<epi::EpiSwiGLU8<false>, pg8::MoeSched, true, true>(c.lds, g, Sd, E); } while (0)
#define GEMM_MOE_DOWN() do { const int ntile = META[0]; MOE_TILE_TABLE(); pg8::Gemm g{HQ, WFF8 + (size_t)NE * 7168 * 1024, 28, 3584u, 128u}; pg8::MoeSched Sd; Sd.init(ntile, 1024, 3584u, 3584u, (size_t)1024 * 3584, c.G, c.bid, te_, nullptr); \
        epi::EpiPlain8 E{YB, 1024, SWD, HSC, c.lds + RING_BYTES + 1024}; pg8::gemm_phase<epi::EpiPlain8, pg8::MoeSched, true, true>(c.lds, g, Sd, E); } while (0)

    PH_BEGIN(0) { int rot = 0; CVQ_WIN(IN(3), 3072, 3072, IN(2), CT_CMAXW0, 1); CVQ_WOUT(IN(4), CT_CMAXO0, 1); } PH_END(0)
    PH_BEGIN(1) { int rot = 0; ph_prep(c, IN(0), H, XQ, RST); CVQ_WIN(IN(3), 3072, 3072, IN(2), CT_CMAXW0, 2); CVQ_WOUT(IN(4), CT_CMAXO0, 2); cvq_ffn(c, IN(13), IN(14), IN(15), IN(12), WFF8, CMAXP(CT_CMAX0), CMAXP(CT_CMAXD0), SWS, SWD, 1, 1, rot); } PH_END(1)
    PH_BEGIN(2) { GEMM_QKV(0, 3072, IN(5), IN(6), false, 0); int rot = 0; cvq_ffn(c, IN(13), IN(14), IN(15), IN(12), WFF8, CMAXP(CT_CMAX0), CMAXP(CT_CMAXD0), SWS, SWD, 1, 2, rot); ph_hidden_scale(c, CMAXP(CT_CMAX0), HSC, 1); CVQ_WIN(IN(17), 3072, 3072, IN(16), CT_CMAXW1, 1); } PH_END(2)
    PH_BEGIN(3) { const float li = 0.2f; ph_diff_attn(c, QKV, AO8, TMP, REL_BIAS, diff_lambda(IN(7), IN(8), IN(9), IN(10), li), IN(11), 1.0f - li); } PH_END(3)
    PH_BEGIN(4) GEMM_WOUT8(1.0f - 0.2f, true, 0); PH_END(4)
    PH_BEGIN(6) GEMM_FFN_UP(0); PH_END(6)
    PH_BEGIN(7) { GEMM_FFN_DOWN(1); int rot = 0; CVQ_WIN(IN(17), 3072, 3072, IN(16), CT_CMAXW1, 2); cv_matrix(c, IN(18), 1024, 1024, 1024, 1024, nullptr, WOUT, 0, rot); cvq_ffn(c, IN(24), IN(25), IN(26), IN(21), WFF8, CMAXP(CT_CMAX1), CMAXP(CT_CMAXD1), SWS, SWD, NE, 1, rot); } PH_END(7)
    PH_BEGIN(9) { GEMM_QKV(0, 3072, IN(19), IN(20), true, 1); int rot = 0; cvq_ffn(c, IN(24), IN(25), IN(26), IN(21), WFF8, CMAXP(CT_CMAX1), CMAXP(CT_CMAXD1), SWS, SWD, NE, 2, rot); ph_hidden_scale(c, CMAXP(CT_CMAX1), HSC, NE); CVQ_WIN(IN(28), 2608, NSA_LD, IN(27), CT_CMAXW2, 1); } PH_END(9)
    PH_BEGIN(10) ph_moba_attn(c, QKV, AO, REL_BIAS); PH_END(10)
    PH_BEGIN(11) GEMM_WOUT(false, 0); PH_END(11)
    PH_BEGIN(12) ph_route_a(c, H, IN(21), IN(22), IN(23), ROUTE, RST, CNT, XQ); PH_END(12)
    PH_BEGIN(13) ph_route_b(c, ROUTE, RST, CNT, SLOT, TOK, RSS, META, XQ, XQS); PH_END(13)
    PH_BEGIN(14) GEMM_MOE_UP(); PH_END(14)
    PH_BEGIN(15) GEMM_MOE_DOWN(); PH_END(15)
    PH_BEGIN(16) { int rot = 0; ph_moe_combine<false>(c, H, YB, ROUTE, SLOT, nullptr, XQ, RST); CVQ_WIN(IN(28), 2608, NSA_LD, IN(27), CT_CMAXW2, 2); cv_matrix(c, IN(29), 1024, 1024, 1024, 1024, nullptr, WOUT, 0, rot);
                   cv_matrix(c, IN(34), 2048, 256, 256, 256, nullptr, CW1, 0, rot); cv_matrix(c, IN(36), 2048, 256, 256, 256, nullptr, CW1 + 256 * 2048, 0, rot);
                   cvq_ffn(c, IN(39), IN(40), IN(41), IN(38), WFF8, CMAXP(CT_CMAX2), CMAXP(CT_CMAXD2), SWS, SWD, 1, 1, rot); ph_cmp_bias(c, IN(32), IN(33), IN(34), IN(36), CB); } PH_END(17)
    PH_BEGIN(17) { GEMM_QKV(2, NSA_LD, IN(30), IN(31), false, 0); int rot = 0; cvq_ffn(c, IN(39), IN(40), IN(41), IN(38), WFF8, CMAXP(CT_CMAX2), CMAXP(CT_CMAXD2), SWS, SWD, 1, 2, rot); ph_hidden_scale(c, CMAXP(CT_CMAX2), HSC, 1); CVQ_WIN(IN(43), 3072, 3072, IN(42), CT_CMAXW3, 1); CVQ_WOUT(IN(44), CT_CMAXO3, 1); } PH_END(17)
    PH_BEGIN(18) { pg8::Gemm g{QKV, CW1, 32, 4096u, (unsigned)NSA_LD * 2u}; pg8::CmpSched Sd{c.G, c.bid, (unsigned)NSA_LD * 2u, 1024u};
                   epi::EpiGelu E{HID, CB}; pg8::gemm_phase<epi::EpiGelu, pg8::CmpSched, true>(c.lds, g, Sd, E); } PH_END(19)
    PH_BEGIN(19) ph_cmp_stage2(c, HID, IN(35), IN(37), IN(31), KCMP, VCMP); PH_END(19)
    PH_BEGIN(20) { ph_nsa_a(c, QKV, KCMP, VCMP, SEL); asm volatile("s_waitcnt vmcnt(0)" ::: "memory"); __syncthreads(); ph_nsa_b(c, QKV, KCMP, VCMP, SEL, AO, REL_BIAS); } PH_END(20)
    PH_BEGIN(21) GEMM_WOUT(true, 2); PH_END(21)
    PH_BEGIN(23) GEMM_FFN_UP(2); PH_END(23)
    PH_BEGIN(24) { GEMM_FFN_DOWN(3); int rot = 0; CVQ_WIN(IN(43), 3072, 3072, IN(42), CT_CMAXW3, 2); CVQ_WOUT(IN(44), CT_CMAXO3, 2); cvq_ffn(c, IN(55), IN(56), IN(57), IN(52), WFF8, CMAXP(CT_CMAX3), CMAXP(CT_CMAXD3), SWS, SWD, NE, 1, rot); } PH_END(24)
    PH_BEGIN(26) { GEMM_QKV(0, 3072, IN(45), IN(46), true, 3); int rot = 0; cvq_ffn(c, IN(55), IN(56), IN(57), IN(52), WFF8, CMAXP(CT_CMAX3), CMAXP(CT_CMAXD3), SWS, SWD, NE, 2, rot); ph_hidden_scale(c, CMAXP(CT_CMAX3), HSC, NE); } PH_END(26)
    PH_BEGIN(27) { const float li = 0.55605818f; ph_diff_attn(c, QKV, AO8, TMP, REL_BIAS, diff_lambda(IN(47), IN(48), IN(49), IN(50), li), IN(51), 1.0f - li); } PH_END(27)
    PH_BEGIN(28) GEMM_WOUT8(1.0f - 0.55605818f, false, 0); PH_END(28)
    PH_BEGIN(29) ph_route_a(c, H, IN(52), IN(53), IN(54), ROUTE, RST, CNT, XQ); PH_END(29)
    PH_BEGIN(30) ph_route_b(c, ROUTE, RST, CNT, SLOT, TOK, RSS, META, XQ, XQS); PH_END(30)
    PH_BEGIN(31) GEMM_MOE_UP(); PH_END(31)
    PH_BEGIN(32) GEMM_MOE_DOWN(); PH_END(32)
    PH_BEGIN(33) ph_moe_combine<true>(c, H, YB, ROUTE, SLOT, OUTF, nullptr, nullptr); PH_END(33)
}

extern "C" void kernel_launch(void* const* d_in, const int* in_sizes, int n_in, void* d_out, int out_size, void* d_ws, size_t ws_size, hipStream_t stream) {
    static int grid = 0;
    if (grid == 0) {
        if (n_in != NIN || in_sizes[0] != T * D || out_size != T * D || ws_size < WS_END) { fprintf(stderr, "kernel_launch: unexpected shapes (n_in %d, in0 %d, out %d, ws %zu)\n", n_in, n_in > 0 ? in_sizes[0] : -1, out_size, ws_size); grid = -1; return; }
        int dev = 0, cus = 0, per_cu = 0;
        if (hipGetDevice(&dev) != hipSuccess || hipDeviceGetAttribute(&cus, hipDeviceAttributeMultiprocessorCount, dev) != hipSuccess) { grid = -1; return; }
        if (hipFuncSetAttribute((const void*)mk_fwd, hipFuncAttributeMaxDynamicSharedMemorySize, LDS_BYTES) != hipSuccess) { grid = -1; return; }
        if (hipOccupancyMaxActiveBlocksPerMultiprocessor(&per_cu, (const void*)mk_fwd, NWAVES * 64, LDS_BYTES) != hipSuccess || per_cu < 1) { fprintf(stderr, "kernel_launch: occupancy query says %d\n", per_cu); }
        (void)hipGetLastError();
        grid = cus;
        if (grid != 256) { fprintf(stderr, "kernel_launch: built for 256 CUs, got %d\n", grid); grid = -1; return; }
    }
    if (grid < 0) return;
    if (hipMemsetAsync((char*)d_ws + WS_CTL, 0, CTL_ZERO_BYTES, stream) != hipSuccess) return;
    Args a{};
    for (int i = 0; i < NIN; ++i) a.in[i] = (const float*)d_in[i];
    a.out = (float*)d_out; a.ws = (unsigned char*)d_ws;
#if MK_PER_PHASE
    for (int p = 0; p < NPH; ++p) { a.ph_lo = p; a.ph_hi = p + 1; hipLaunchKernelGGL(mk_fwd, dim3(grid), dim3(NWAVES * 64), LDS_BYTES, stream, a); }
#else
    a.ph_lo = 0; a.ph_hi = NPH;
    hipLaunchKernelGGL(mk_fwd, dim3(grid), dim3(NWAVES * 64), LDS_BYTES, stream, a);
#endif
}
```
